# Optimizing an MI355X kernel written in HIP

```python
import jax, jax.numpy as jnp
from jax import lax
import numpy as np

D_MODEL = 4096
BATCH = 1
SEQ = 8192
DEPTH = 1

EPS = 1e-6
POOL_WIDTH = D_MODEL // 2
POOL_WINDOWS = (2, 4, 8, 16)
N_POOL_GROUPS = len(POOL_WINDOWS)
POOL_GROUP = POOL_WIDTH // N_POOL_GROUPS
HGRN_WIDTH = D_MODEL // 2
HGRN_HEAD_DIM = 128
HGRN_HEADS = HGRN_WIDTH // HGRN_HEAD_DIM
CHUNK = 64
D_FF = -(-8 * D_MODEL // (3 * 256)) * 256
N_IN = POOL_WIDTH + 4 * HGRN_WIDTH + 2 * D_MODEL
SPLITS = (POOL_WIDTH,
          POOL_WIDTH + HGRN_WIDTH,
          POOL_WIDTH + 2 * HGRN_WIDTH,
          POOL_WIDTH + 3 * HGRN_WIDTH,
          POOL_WIDTH + 4 * HGRN_WIDTH,
          POOL_WIDTH + 4 * HGRN_WIDTH + D_MODEL)

kernel_name = "hybrid_pool_hgrn2_gated_block"


def rms_norm(x, w):
    xf = x.astype(jnp.float32)
    y = xf * lax.rsqrt(jnp.mean(xf * xf, axis=-1, keepdims=True) + EPS)
    return (y * w.astype(jnp.float32)).astype(x.dtype)


def causal_multiscale_pool(z):
    B, T, _ = z.shape
    zf = z.astype(jnp.float32).reshape(B, T, N_POOL_GROUPS, POOL_GROUP)
    cs = jnp.concatenate([jnp.zeros((B, 1, N_POOL_GROUPS, POOL_GROUP), jnp.float32),
                          jnp.cumsum(zf, axis=1)], axis=1)
    t = jnp.arange(T)
    outs = []
    for gi, w in enumerate(POOL_WINDOWS):
        start = jnp.maximum(t + 1 - w, 0)
        window_sum = cs[:, 1:, gi] - cs[:, start, gi]
        count = (t + 1 - start).astype(jnp.float32)[None, :, None]
        outs.append(window_sum / count)
    pooled = jnp.stack(outs, axis=2)
    return pooled - zf


def hgrn2_chunkwise(q, k, v, log_f):
    B, T, H, DK = q.shape
    DV = v.shape[-1]
    n = T // CHUNK

    def to_chunks(a):
        return a.reshape(B, n, CHUNK, H, a.shape[-1]).transpose(1, 0, 3, 2, 4)

    qc, kc, vc, gc = to_chunks(q), to_chunks(k), to_chunks(v), to_chunks(log_f)
    causal = jnp.tril(jnp.ones((CHUNK, CHUNK), dtype=bool))[:, :, None]

    def step(S, inp):
        qb, kb, vb, gb = inp
        b = jnp.cumsum(gb, axis=2)
        diff = b[:, :, :, None, :] - b[:, :, None, :, :]
        decay = jnp.exp(jnp.where(causal, diff, -jnp.inf))
        scores = jnp.einsum('bhtk,bhtsk,bhsk->bhts', qb, decay, kb)
        o_intra = jnp.einsum('bhts,bhsv->bhtv', scores, vb)
        o_inter = jnp.einsum('bhtk,bhkv->bhtv', qb * jnp.exp(b), S)
        b_end = b[:, :, -1:, :]
        k_dec = kb * jnp.exp(b_end - b)
        S_new = jnp.exp(b_end[:, :, 0, :])[..., None] * S + jnp.einsum('bhsk,bhsv->bhkv', k_dec, vb)
        return S_new, o_intra + o_inter

    S0 = jnp.zeros((B, H, DK, DV), jnp.float32)
    _, ys = lax.scan(step, S0, (qc, kc, vc, gc))
    return ys.transpose(1, 0, 3, 2, 4).reshape(B, T, H, DV)


def setup_inputs(seed: int = 0) -> dict:
    key = jax.random.key(seed)
    ks = jax.random.split(key, 16)
    f32 = jnp.float32

    def dense(k, shape, fan_in):
        return jax.random.normal(k, shape, f32) * (fan_in ** -0.5)

    def gain(k, shape):
        return 1.0 + 0.02 * jax.random.normal(k, shape, f32)

    L = DEPTH
    return {
        "x": jax.random.normal(ks[0], (BATCH, SEQ, D_MODEL), f32),
        "g_mix": gain(ks[1], (L, D_MODEL)),
        "w_in": dense(ks[2], (L, D_MODEL, N_IN), D_MODEL),
        "w_pool_group": dense(ks[3], (L, N_POOL_GROUPS, POOL_GROUP, POOL_GROUP), POOL_GROUP),
        "pool_scale": gain(ks[4], (L, POOL_WIDTH)),
        "lb_param": 0.5 * jax.random.normal(ks[5], (L + 1, HGRN_WIDTH), f32),
        "hgrn_norm": gain(ks[6], (L, HGRN_WIDTH)),
        "w_up_pool": dense(ks[7], (L, POOL_WIDTH, D_MODEL), POOL_WIDTH),
        "w_up_hgrn": dense(ks[8], (L, HGRN_WIDTH, D_MODEL), HGRN_WIDTH),
        "w_out": dense(ks[9], (L, D_MODEL, D_MODEL), D_MODEL),
        "g_ffn": gain(ks[10], (L, D_MODEL)),
        "w_ffn_gate": dense(ks[11], (L, D_MODEL, D_FF), D_MODEL),
        "w_ffn_up": dense(ks[12], (L, D_MODEL, D_FF), D_MODEL),
        "w_ffn_down": dense(ks[13], (L, D_FF, D_MODEL), D_FF),
        "g_final": gain(ks[14], (D_MODEL,)),
    }


def reference(x, g_mix, w_in, w_pool_group, pool_scale, lb_param, hgrn_norm,
              w_up_pool, w_up_hgrn, w_out, g_ffn, w_ffn_gate, w_ffn_up, w_ffn_down, g_final):
    B, T, _ = x.shape
    f32 = jnp.float32
    lower_bounds = jnp.cumsum(jax.nn.softmax(lb_param.astype(f32), axis=0), axis=0)

    def heads(a):
        return a.reshape(B, T, HGRN_HEADS, HGRN_HEAD_DIM)

    h = x
    for l in range(DEPTH):
        u = rms_norm(h, g_mix[l])
        proj = u @ w_in[l]
        z_pool, q, f_logit, i_in, o_gate, gate_a, gate_b = jnp.split(proj, SPLITS, axis=-1)

        pooled = causal_multiscale_pool(z_pool).astype(x.dtype)
        y_pool = jnp.einsum('btng,nge->btne', pooled, w_pool_group[l])
        y_pool = (y_pool * pool_scale[l].reshape(N_POOL_GROUPS, POOL_GROUP)).reshape(B, T, POOL_WIDTH)

        lb = lower_bounds[l]
        f = lb + (1.0 - lb) * jax.nn.sigmoid(f_logit.astype(f32))
        k = 1.0 - f
        log_f = jnp.log(f)
        qh = jax.nn.silu(q.astype(f32))
        o = hgrn2_chunkwise(heads(qh), heads(k), heads(i_in.astype(f32)), heads(log_f))
        o = rms_norm(o, hgrn_norm[l].reshape(HGRN_HEADS, HGRN_HEAD_DIM))
        y_hgrn = (o.reshape(B, T, HGRN_WIDTH) * jax.nn.silu(o_gate.astype(f32))).astype(x.dtype)

        merged = (jax.nn.sigmoid(gate_a) * (y_pool @ w_up_pool[l])
                  + jax.nn.sigmoid(gate_b) * (y_hgrn @ w_up_hgrn[l]))
        h = h + merged @ w_out[l]

        v = rms_norm(h, g_ffn[l])
        h = h + (jax.nn.silu(v @ w_ffn_gate[l]) * (v @ w_ffn_up[l])) @ w_ffn_down[l]

    return rms_norm(h, g_final)
```

```cpp
#include <hip/hip_runtime.h>
#include <cstdio>
#include <cstdint>

#ifndef MK_N_LAUNCHES
#define MK_N_LAUNCHES 1
#endif

namespace pg8 {
#define PG8_LAS __attribute__((address_space(3)))
typedef unsigned short bf16_t;
typedef short bf16x8 __attribute__((ext_vector_type(8)));
typedef float f32x4 __attribute__((ext_vector_type(4)));
typedef unsigned u32x4 __attribute__((ext_vector_type(4)));
typedef unsigned u32x2 __attribute__((ext_vector_type(2)));
constexpr int BM = 256, BK = 64, HALF = 128, HTB = HALF * BK * 2  , STAGE_BYTES = 8 * HTB, NXCD = 8, WGM = 8;

__host__ __device__ __forceinline__ int lds_byte(int r, int c) { const int st = (r >> 4) * 2 + (c >> 5), rr = r & 15, cc = c & 31, ob = rr * 64 + cc * 2; return st * 1024 + (ob ^ (((ob >> 9) & 1) << 5)); }
__host__ __device__ __forceinline__ void stage_rc(int b, int& R, int& C) { const int st = b / 1024, sb = b % 1024, swz = sb ^ (((sb >> 9) & 1) << 5); R = (st >> 1) * 16 + swz / 64; C = (st & 1) * 32 + (swz % 64) / 2; }
__host__ __device__ __forceinline__ int perm32(int rho) { const int n = rho >> 4, i = rho & 15; return 8 * (i >> 2) + 4 * n + (i & 3); }

struct Unit { int pm, pn; };
struct Gemm { const bf16_t* A; const bf16_t* Bt; int M, N, K, lda, ldb, agrp_shift, agrp_stride; };

struct StaticOrder {
    int nM, nN, nwg, G, c;
    __host__ __device__ void init(int M, int N, int G_, int c_) { nM = M / BM; nN = N / BM; nwg = nM * nN; G = G_; c = c_; }
    __host__ __device__ bool next(int i, Unit& u) const {
        const long L = (long)i * G + c; if (L >= nwg) return false;
        int wgid = (int)L; { const int q = nwg / NXCD, r = nwg % NXCD, xcd = wgid % NXCD, off = wgid / NXCD; wgid = (xcd < r ? xcd * (q + 1) : r * (q + 1) + (xcd - r) * q) + off; }
        const int nig = WGM * nN, gid = wgid / nig, fm = gid * WGM, gsz = (nM - fm) < WGM ? (nM - fm) : WGM;
        u.pm = fm + ((wgid % nig) % gsz); u.pn = (wgid % nig) / gsz; return true;
    }
    __device__ __forceinline__ void a_ready(const Unit&) const {}
    __device__ __forceinline__ void done(const Unit&) const {}
};

__device__ __forceinline__ unsigned cvt_pk_bf16(float lo, float hi) { unsigned r; asm volatile("v_cvt_pk_bf16_f32 %0, %1, %2" : "=v"(r) : "v"(lo), "v"(hi)); return r; }
__device__ __forceinline__ float bf_lo(unsigned w) { return __uint_as_float(w << 16); }
__device__ __forceinline__ float bf_hi(unsigned w) { return __uint_as_float(w & 0xffff0000u); }
__device__ __forceinline__ float fsigmoid(float x) { return __builtin_amdgcn_rcpf(1.0f + __expf(-x)); }
__device__ __forceinline__ float fsilu(float x) { return x * fsigmoid(x); }

template <class Epi, class Sched, bool ALIGN_EPI = false, bool SP2 = false>
__device__ __forceinline__ void gemm_phase(PG8_LAS unsigned char* lds, const Gemm g, const Sched& S, const Epi& E) {
    const int tid = threadIdx.x, wid = __builtin_amdgcn_readfirstlane(tid >> 6), lane = tid & 63, wr = wid >> 2, wc = wid & 3, fr = lane & 15, fq = lane >> 4;
    const int K = g.K, nt = K / BK;
    unsigned voffA[2], voffB[2];
#pragma unroll
    for (int i = 0; i < 2; ++i) { int R, C; stage_rc(tid * 16 + i * 8192, R, C); const int Rb = Epi::PERM ? ((R & ~31) + perm32(R & 31)) : R;
        voffA[i] = (unsigned)(R * g.lda + C) * 2u; voffB[i] = (unsigned)(Rb * g.ldb + C) * 2u; }
    const size_t kstep = (size_t)(BK * 2);
    const size_t hstepA = (size_t)HALF * g.lda * 2, hstepB = (size_t)HALF * g.ldb * 2;
    const size_t tstepA = 2 * hstepA, tstepB = 2 * hstepB;
    const unsigned ldsw = (unsigned)wid * 1024u;
    const int aoff = lds_byte(wr * 64 + fr, fq * 8), boff = lds_byte(wc * 32 + fr, fq * 8);
#define PG8_SA(b, h) (((b) * 2 + (h)) * HTB)
#define PG8_SB(b, h) ((4 + (b) * 2 + (h)) * HTB)
#define PG8_STAGE(bufoff, gbase, voff) do { _Pragma("unroll") for (int _i = 0; _i < 2; ++_i) \
        __builtin_amdgcn_global_load_lds((const unsigned*)((const char*)(gbase) + (voff)[_i]), (PG8_LAS unsigned*)(lds + (bufoff) + ldsw + _i * 8192), 16, 0, 0); } while (0)
#define PG8_LDA(dst, b, h) do { _Pragma("unroll") for (int m = 0; m < 4; ++m) _Pragma("unroll") for (int k = 0; k < 2; ++k) dst[m][k] = *(const PG8_LAS bf16x8*)(lds + PG8_SA(b, h) + aoff + m * 2048 + k * 1024); } while (0)
#define PG8_LDB(dst, b, h) do { _Pragma("unroll") for (int n = 0; n < 2; ++n) _Pragma("unroll") for (int k = 0; k < 2; ++k) dst[n][k] = *(const PG8_LAS bf16x8*)(lds + PG8_SB(b, h) + boff + n * 2048 + k * 1024); } while (0)
#define PG8_MMA(ai, bj, At, Bt) do { __builtin_amdgcn_s_setprio(1); _Pragma("unroll") for (int m = 0; m < 4; ++m) _Pragma("unroll") for (int n = 0; n < 2; ++n) _Pragma("unroll") for (int k = 0; k < 2; ++k) \
        acc[ai][bj][m][n] = __builtin_amdgcn_mfma_f32_16x16x32_bf16(Bt[n][k], At[m][k], acc[ai][bj][m][n], 0, 0, 0); __builtin_amdgcn_s_setprio(0); } while (0)
#define PG8_WAIT_V(n) asm volatile("s_waitcnt vmcnt(" #n ")" ::: "memory")
#define PG8_WAIT_L(n) asm volatile("s_waitcnt lgkmcnt(" #n ")" ::: "memory")
#define PG8_BAR __builtin_amdgcn_s_barrier()
#define PG8_SCHED __builtin_amdgcn_sched_barrier(0)
#define PG8_ABASE(u) ((const char*)g.A + (size_t)(u).pm * tstepA + (g.agrp_stride ? (size_t)(((u).pn >> g.agrp_shift) * g.agrp_stride) * 2 : (size_t)0))
    Unit cur, nxt; int ui = 0;
    if (!S.next(0, cur)) return;
    f32x4 acc[2][2][4][2];
#pragma unroll
    for (int a = 0; a < 2; ++a)
#pragma unroll
        for (int b = 0; b < 2; ++b)
#pragma unroll
            for (int m = 0; m < 4; ++m)
#pragma unroll
                for (int n = 0; n < 2; ++n) acc[a][b][m][n] = (f32x4){0.f, 0.f, 0.f, 0.f};
    bf16x8 At[4][2], B0[2][2], B1[2][2];
    const char* cA = PG8_ABASE(cur); const char* cB = (const char*)g.Bt + (size_t)cur.pn * tstepB;
    S.a_ready(cur);
    if constexpr (SP2) {
        PG8_STAGE(PG8_SB(0, 0), cB, voffB); PG8_STAGE(PG8_SB(0, 1), cB + hstepB, voffB); PG8_STAGE(PG8_SA(0, 0), cA, voffA); PG8_STAGE(PG8_SA(0, 1), cA + hstepA, voffA);
        if (wr == 1) PG8_BAR;
        PG8_WAIT_V(2); PG8_BAR;
        PG8_STAGE(PG8_SB(1, 0), cB + kstep, voffB); PG8_STAGE(PG8_SA(1, 0), cA + kstep, voffA); PG8_STAGE(PG8_SB(1, 1), cB + hstepB + kstep, voffB);
        PG8_WAIT_V(6); PG8_BAR;
    } else {
        PG8_STAGE(PG8_SB(0, 0), cB, voffB); PG8_STAGE(PG8_SA(0, 0), cA, voffA); PG8_STAGE(PG8_SB(0, 1), cB + hstepB, voffB); PG8_STAGE(PG8_SA(0, 1), cA + hstepA, voffA);
        if (wr == 1) PG8_BAR;
        PG8_WAIT_V(4); PG8_BAR;
        PG8_STAGE(PG8_SB(1, 0), cB + kstep, voffB); PG8_STAGE(PG8_SA(1, 0), cA + kstep, voffA); PG8_STAGE(PG8_SB(1, 1), cB + hstepB + kstep, voffB);
        PG8_WAIT_V(6); PG8_BAR;
    }
    for (;;) {
        const bool has_next = S.next(ui + 1, nxt);
        const char* nA = has_next ? PG8_ABASE(nxt) : cA; const char* nB = has_next ? (const char*)g.Bt + (size_t)nxt.pn * tstepB : cB;
        for (int t = 0; t < nt; t += 2) {
            const bool last = (t == nt - 2);
            const char* a1 = cA + (size_t)(t + 1) * kstep;
            const char* a2 = last ? nA : cA + (size_t)(t + 2) * kstep; const char* b2 = last ? nB : cB + (size_t)(t + 2) * kstep;
            const char* a3 = a2 + kstep; const char* b3 = b2 + kstep;
            if (last && has_next) S.a_ready(nxt);
            if constexpr (SP2) {
            PG8_LDB(B0, 0, 0); PG8_LDB(B1, 0, 1); PG8_SCHED; PG8_LDA(At, 0, 0); PG8_STAGE(PG8_SA(1, 1), a1 + hstepA, voffA);
            PG8_WAIT_V(8); PG8_WAIT_L(0); PG8_BAR; PG8_MMA(0, 0, At, B0); PG8_MMA(0, 1, At, B1); PG8_BAR; PG8_SCHED;
            PG8_LDA(At, 0, 1); PG8_STAGE(PG8_SB(0, 0), b2, voffB); PG8_STAGE(PG8_SB(0, 1), b2 + hstepB, voffB); PG8_STAGE(PG8_SA(0, 0), a2, voffA);
            PG8_WAIT_V(8); PG8_WAIT_L(0); PG8_BAR; PG8_MMA(1, 0, At, B0); PG8_MMA(1, 1, At, B1); PG8_BAR; PG8_SCHED;
            PG8_LDB(B0, 1, 0); PG8_LDB(B1, 1, 1); PG8_SCHED; PG8_LDA(At, 1, 0); PG8_STAGE(PG8_SA(0, 1), a2 + hstepA, voffA);
            PG8_WAIT_V(8); PG8_WAIT_L(0); PG8_BAR; PG8_MMA(0, 0, At, B0); PG8_MMA(0, 1, At, B1); PG8_BAR; PG8_SCHED;
            PG8_LDA(At, 1, 1); PG8_STAGE(PG8_SB(1, 0), b3, voffB); PG8_STAGE(PG8_SB(1, 1), b3 + hstepB, voffB); PG8_STAGE(PG8_SA(1, 0), a3, voffA);
            PG8_WAIT_V(8); PG8_WAIT_L(0); PG8_BAR; PG8_MMA(1, 0, At, B0); PG8_MMA(1, 1, At, B1); PG8_BAR; PG8_SCHED;
            } else {
            PG8_LDB(B0, 0, 0); PG8_SCHED; PG8_LDA(At, 0, 0); PG8_STAGE(PG8_SA(1, 1), a1 + hstepA, voffA);
            PG8_WAIT_L(8); PG8_BAR; PG8_WAIT_L(0); PG8_MMA(0, 0, At, B0); PG8_BAR; PG8_SCHED;
            PG8_LDB(B1, 0, 1); PG8_STAGE(PG8_SB(0, 0), b2, voffB);
            PG8_BAR; PG8_WAIT_L(0); PG8_MMA(0, 1, At, B1); PG8_BAR;
            PG8_LDA(At, 0, 1); PG8_STAGE(PG8_SA(0, 0), a2, voffA);
            PG8_BAR; PG8_WAIT_L(0); PG8_MMA(1, 0, At, B0); PG8_BAR; PG8_SCHED;
            PG8_STAGE(PG8_SB(0, 1), b2 + hstepB, voffB);
            PG8_WAIT_V(6); PG8_BAR; PG8_MMA(1, 1, At, B1); PG8_BAR;
            PG8_LDB(B0, 1, 0); PG8_SCHED; PG8_LDA(At, 1, 0); PG8_STAGE(PG8_SA(0, 1), a2 + hstepA, voffA);
            PG8_WAIT_L(8); PG8_BAR; PG8_WAIT_L(0); PG8_MMA(0, 0, At, B0); PG8_BAR; PG8_SCHED;
            PG8_LDB(B1, 1, 1); PG8_STAGE(PG8_SB(1, 0), b3, voffB);
            PG8_BAR; PG8_WAIT_L(0); PG8_MMA(0, 1, At, B1); PG8_BAR;
            PG8_LDA(At, 1, 1); PG8_STAGE(PG8_SA(1, 0), a3, voffA);
            PG8_BAR; PG8_WAIT_L(0); PG8_MMA(1, 0, At, B0); PG8_BAR; PG8_SCHED;
            PG8_STAGE(PG8_SB(1, 1), b3 + hstepB, voffB);
            PG8_WAIT_V(6); PG8_BAR; PG8_MMA(1, 1, At, B1); PG8_BAR;
            }
        }
        if constexpr (ALIGN_EPI) { if (wr == 0) PG8_BAR; }
        E(acc, cur, wr, wc, fr, fq); S.done(cur);
        if (!has_next) break;
#pragma unroll
        for (int a = 0; a < 2; ++a)
#pragma unroll
            for (int b = 0; b < 2; ++b)
#pragma unroll
                for (int m = 0; m < 4; ++m)
#pragma unroll
                    for (int n = 0; n < 2; ++n) acc[a][b][m][n] = (f32x4){0.f, 0.f, 0.f, 0.f};
        cur = nxt; cA = nA; cB = nB; ++ui;
        if constexpr (ALIGN_EPI) { if (wr == 1) PG8_BAR; }
    }
    PG8_WAIT_V(0);
    if constexpr (!ALIGN_EPI) { if (wr == 0) PG8_BAR; }
    PG8_BAR;
#undef PG8_ABASE
#undef PG8_SA
#undef PG8_SB
#undef PG8_STAGE
#undef PG8_LDA
#undef PG8_LDB
#undef PG8_MMA
#undef PG8_WAIT_V
#undef PG8_WAIT_L
#undef PG8_BAR
#undef PG8_SCHED
}
}

constexpr int NWAVES = 8;
constexpr int T = 8192, D = 4096, PW = 2048, HW = 2048, NH = 16, HD = 128, DFF = 11008;
constexpr int NIN = PW + 4 * HW + 2 * D;
constexpr float EPS = 1e-6f;
constexpr int NPHASE = 10;
constexpr int N_LAUNCHES = MK_N_LAUNCHES;

constexpr size_t MiB = 1u << 20;
constexpr size_t WS_CTL = 0, CTL_ZERO_BYTES = 1 * MiB;
constexpr size_t WS_WIN = 1 * MiB;
constexpr size_t WS_WPG = WS_WIN + 144 * MiB;
constexpr size_t WS_WUP = WS_WPG + 2 * MiB;
constexpr size_t WS_WUH = WS_WUP + 16 * MiB;
constexpr size_t WS_WO = WS_WUH + 16 * MiB;
constexpr size_t WS_WGU = WS_WO + 32 * MiB;
constexpr size_t WS_WD = WS_WGU + 172 * MiB;
constexpr size_t WS_U = WS_WD + 86 * MiB;
constexpr size_t WS_PROJ = WS_U + 64 * MiB;
constexpr size_t WS_Z = WS_PROJ, WS_QS = WS_Z + 32 * MiB, WS_G = WS_QS + 32 * MiB, WS_KK = WS_G + 32 * MiB, WS_V = WS_KK + 32 * MiB, WS_OG = WS_V + 32 * MiB;
constexpr size_t WS_GA = WS_OG + 32 * MiB, WS_GB = WS_GA + 64 * MiB;
constexpr size_t WS_ACT = WS_PROJ;
constexpr size_t WS_P = WS_PROJ + 320 * MiB;
constexpr size_t WS_YP = WS_P + 32 * MiB, WS_YH = WS_YP + 32 * MiB;
constexpr size_t WS_H1B = WS_YH + 32 * MiB;
constexpr size_t WS_O = WS_H1B + 64 * MiB;
constexpr size_t WS_SSQ1 = WS_O + 64 * MiB, WS_SSQ2 = WS_SSQ1 + 2 * MiB, WS_RS1 = WS_SSQ2 + 2 * MiB;
constexpr size_t WS_END = WS_RS1 + 1 * MiB;
static_assert(WS_ACT + (size_t)T * DFF * 2 <= WS_P, "ACT overlay fits the projection region");

constexpr int RING_OFF = 0, RING_BYTES = 131072;
constexpr int LDSCTL_OFF = RING_BYTES, MISC_OFF = LDSCTL_OFF + 320;
constexpr int LDS_BYTES = 147456;
static_assert(MISC_OFF + 128 <= LDS_BYTES, "LDS map");

#define GAS __attribute__((address_space(1)))
#define LAS __attribute__((address_space(3)))
typedef unsigned short bf16;
typedef unsigned v4u __attribute__((ext_vector_type(4)));
typedef unsigned v2u __attribute__((ext_vector_type(2)));
typedef float f32x4 __attribute__((ext_vector_type(4)));
typedef GAS unsigned gu32;
#define RLX_AGENT __ATOMIC_RELAXED, __HIP_MEMORY_SCOPE_AGENT
#define LDS_WAIT() asm volatile("s_waitcnt lgkmcnt(0)" ::: "memory")
#define VM_WAIT() asm volatile("s_waitcnt vmcnt(0)" ::: "memory")
__device__ __forceinline__ unsigned f2bf(float f) { unsigned u = __builtin_bit_cast(unsigned, f); return (u + 0x7fffu + ((u >> 16) & 1u)) >> 16; }
__device__ __forceinline__ unsigned pk2(float lo, float hi) { return f2bf(lo) | (f2bf(hi) << 16); }
__device__ __forceinline__ float bf2f(unsigned short b) { return __uint_as_float(((unsigned)b) << 16); }

#define XB_TMO      128
#define XB_XCNT(j)  (256  + 64 * (j))
#define XB_XSUB(j)  (1280 + 64 * (j))
#define XB_XGEN(j)  (2304 + 64 * (j))
#define XB_TOP      3328
#define XB_TOPGEN   3392
#define XCD_BAR_WORDS 3456
#define XB_SPIN_CAP (1u << 18)
__device__ __forceinline__ unsigned xb_ld(unsigned* p)              { return __hip_atomic_load(p, __ATOMIC_RELAXED, __HIP_MEMORY_SCOPE_AGENT); }
__device__ __forceinline__ unsigned xb_add(unsigned* p, unsigned v) { return __hip_atomic_fetch_add(p, v, __ATOMIC_RELAXED, __HIP_MEMORY_SCOPE_AGENT); }
__device__ __forceinline__ unsigned xb_xcc_id() { return (unsigned)__builtin_amdgcn_s_getreg((3 << 11) | 20) & 0xFu; }
#define XB_SPIN(cond, bar) do { unsigned _sp = 0; while (cond) { __builtin_amdgcn_s_sleep(1); \
    if ((++_sp & 255u) == 0u) { if (xb_ld(&(bar)[XB_TMO])) break; if (_sp > XB_SPIN_CAP) { atomicAdd(&(bar)[XB_TMO], 1u); break; } } } } while (0)
struct XcdBarrier { unsigned* bar; unsigned x; volatile LAS unsigned* st; };
__device__ __forceinline__ XcdBarrier xcd_barrier_post(unsigned* bar, volatile LAS unsigned* st) {
    XcdBarrier b; b.bar = bar; b.x = xb_xcc_id(); b.st = st;
    if (threadIdx.x == 0) (void)xb_add(&bar[XB_XCNT(b.x)], 1u);
    return b;
}
__device__ __forceinline__ void xcd_barrier_complete(unsigned* bar, unsigned x, unsigned& nloc, unsigned& nx) {
    const unsigned G = gridDim.x * gridDim.y * gridDim.z;
    unsigned sum, cnt, mine, sp = 0u;
    for (;;) {
        sum = 0u; cnt = 0u; mine = 0u;
#pragma unroll
        for (unsigned j = 0; j < 16; ++j) { const unsigned c = xb_ld(&bar[XB_XCNT(j)]); sum += c; cnt += (c > 0u) ? 1u : 0u; mine = (j == x) ? c : mine; }
        if (sum == G) break;
        __builtin_amdgcn_s_sleep(1);
        if ((++sp & 255u) == 0u) { if (xb_ld(&bar[XB_TMO])) break; if (sp > XB_SPIN_CAP) { atomicAdd(&bar[XB_TMO], 1u); break; } }
    }
    nloc = mine > 0u ? mine : 1u; nx = cnt > 0u ? cnt : 1u;
}
__device__ __forceinline__ void xcd_barrier(const XcdBarrier& b) {
    asm volatile("s_waitcnt vmcnt(0)" ::: "memory");
    __syncthreads();
    if (threadIdx.x == 0) {
        unsigned* bar = b.bar;
        __builtin_amdgcn_s_waitcnt(0);
        unsigned nloc = b.st[0], nx = b.st[1];
        if (nloc == 0u) { xcd_barrier_complete(bar, b.x, nloc, nx); b.st[0] = nloc; b.st[1] = nx; }
        const unsigned old = xb_add(&bar[XB_XSUB(b.x)], 1u);
        const unsigned gen = old / nloc;
        if (old + 1u == (gen + 1u) * nloc) {
            __builtin_amdgcn_fence(__ATOMIC_RELEASE, "agent");
            asm volatile("s_waitcnt vmcnt(0)" ::: "memory");
            const unsigned og = xb_add(&bar[XB_TOP], 1u);
            const unsigned tg = og / nx;
            if (og + 1u == (tg + 1u) * nx) xb_add(&bar[XB_TOPGEN], 1u);
            else XB_SPIN(xb_ld(&bar[XB_TOPGEN]) == tg, bar);
            __builtin_amdgcn_fence(__ATOMIC_ACQUIRE, "agent");
            xb_add(&bar[XB_XGEN(b.x)], 1u);
            asm volatile("s_waitcnt vmcnt(0)" ::: "memory");
        } else {
            XB_SPIN(xb_ld(&bar[XB_XGEN(b.x)]) == gen, bar);
            __builtin_amdgcn_fence(__ATOMIC_ACQUIRE, "agent");
            asm volatile("s_waitcnt vmcnt(0)" ::: "memory");
        }
    }
    __syncthreads();
}

using pg8::Unit; using pg8::cvt_pk_bf16; using pg8::fsigmoid; using pg8::fsilu; using pg8::bf_lo; using pg8::bf_hi;
constexpr int BM = 256, HALF = 128;

struct EpiProj {
    static constexpr bool PERM = true;
    bf16* PROJ; const float* lbp;
    __device__ __forceinline__ void operator()(const f32x4 (&acc)[2][2][4][2], const Unit& u, int wr, int wc, int fr, int fq) const {
        const int row0 = u.pm * BM + wr * 64 + fr; const int cls = u.pn >> 3;
        int ldc, colt; size_t toff;
        if (cls < 5) { ldc = 2048; colt = (u.pn & 7) * 256; toff = (size_t)(cls + (cls >= 3 ? 1 : 0)) * ((size_t)T * 2048); }
        else { ldc = 4096; colt = (u.pn - (cls < 7 ? 40 : 56)) * 256; toff = (size_t)6 * ((size_t)T * 2048) + (cls < 7 ? (size_t)0 : (size_t)T * 4096); }
        bf16* base = PROJ + toff; bf16* G = PROJ + (size_t)2 * T * 2048; bf16* KK = PROJ + (size_t)3 * T * 2048;
        const int col0 = colt + wc * 32 + 8 * fq;
        if (cls == 2) {
            float lb[2][8];
#pragma unroll
            for (int bj = 0; bj < 2; ++bj) {
                const f32x4 p0a = *(const f32x4*)(lbp + col0 + bj * HALF), p0b = *(const f32x4*)(lbp + col0 + bj * HALF + 4);
                const f32x4 p1a = *(const f32x4*)(lbp + HW + col0 + bj * HALF), p1b = *(const f32x4*)(lbp + HW + col0 + bj * HALF + 4);
#pragma unroll
                for (int j = 0; j < 4; ++j) { lb[bj][j] = __builtin_amdgcn_rcpf(1.0f + __expf(p1a[j] - p0a[j])); lb[bj][4 + j] = __builtin_amdgcn_rcpf(1.0f + __expf(p1b[j] - p0b[j])); }
            }
#pragma unroll
            for (int ai = 0; ai < 2; ++ai)
#pragma unroll
                for (int m = 0; m < 4; ++m) { const size_t ro = (size_t)(row0 + ai * HALF + m * 16) * 2048 + col0;
#pragma unroll
                    for (int bj = 0; bj < 2; ++bj) { float gl[8], kv[8];
#pragma unroll
                        for (int n = 0; n < 2; ++n)
#pragma unroll
                            for (int j = 0; j < 4; ++j) { const float x = fminf(fmaxf(acc[ai][bj][m][n][j], -80.f), 80.f); const float e = __expf(-x); const float sg = __builtin_amdgcn_rcpf(1.0f + e); const float l = lb[bj][4 * n + j];
                                const float f = l + (1.0f - l) * sg; gl[4 * n + j] = __logf(f); kv[4 * n + j] = (1.0f - l) * (e * sg); }
                        pg8::u32x4 w; w.x = cvt_pk_bf16(gl[0], gl[1]); w.y = cvt_pk_bf16(gl[2], gl[3]); w.z = cvt_pk_bf16(gl[4], gl[5]); w.w = cvt_pk_bf16(gl[6], gl[7]);
                        *(pg8::u32x4*)(G + ro + bj * HALF) = w;
                        w.x = cvt_pk_bf16(kv[0], kv[1]); w.y = cvt_pk_bf16(kv[2], kv[3]); w.z = cvt_pk_bf16(kv[4], kv[5]); w.w = cvt_pk_bf16(kv[6], kv[7]);
                        *(pg8::u32x4*)(KK + ro + bj * HALF) = w; } }
            return;
        }
        const int act = (cls == 0 || cls == 3) ? 0 : (cls == 1 || cls == 4) ? 1 : 2;
#pragma unroll
        for (int ai = 0; ai < 2; ++ai)
#pragma unroll
            for (int m = 0; m < 4; ++m) { bf16* rowp = base + (size_t)(row0 + ai * HALF + m * 16) * ldc + col0;
#pragma unroll
                for (int bj = 0; bj < 2; ++bj) { f32x4 v0 = acc[ai][bj][m][0], v1 = acc[ai][bj][m][1];
                    if (act != 0) {
#pragma unroll
                        for (int j = 0; j < 4; ++j) { const float s0 = fsigmoid(v0[j]), s1 = fsigmoid(v1[j]); v0[j] = act == 1 ? v0[j] * s0 : s0; v1[j] = act == 1 ? v1[j] * s1 : s1; } }
                    pg8::u32x4 w; w.x = cvt_pk_bf16(v0[0], v0[1]); w.y = cvt_pk_bf16(v0[2], v0[3]); w.z = cvt_pk_bf16(v1[0], v1[1]); w.w = cvt_pk_bf16(v1[2], v1[3]);
                    *(pg8::u32x4*)(rowp + bj * HALF) = w; } }
    }
};
struct EpiScaleBf16 {
    static constexpr bool PERM = true;
    bf16* O; int ldc; const float* scale;
    __device__ __forceinline__ void operator()(const f32x4 (&acc)[2][2][4][2], const Unit& u, int wr, int wc, int fr, int fq) const {
        const int row0 = u.pm * BM + wr * 64 + fr, col0 = u.pn * BM + wc * 32 + 8 * fq;
        f32x4 sv[2][2];
#pragma unroll
        for (int bj = 0; bj < 2; ++bj)
#pragma unroll
            for (int n = 0; n < 2; ++n) sv[bj][n] = *(const f32x4*)(scale + col0 + bj * HALF + 4 * n);
#pragma unroll
        for (int ai = 0; ai < 2; ++ai)
#pragma unroll
            for (int m = 0; m < 4; ++m) { bf16* rowp = O + (size_t)(row0 + ai * HALF + m * 16) * ldc + col0;
#pragma unroll
                for (int bj = 0; bj < 2; ++bj) { const f32x4 v0 = acc[ai][bj][m][0] * sv[bj][0], v1 = acc[ai][bj][m][1] * sv[bj][1];
                    pg8::u32x4 w; w.x = cvt_pk_bf16(v0[0], v0[1]); w.y = cvt_pk_bf16(v0[2], v0[3]); w.z = cvt_pk_bf16(v1[0], v1[1]); w.w = cvt_pk_bf16(v1[2], v1[3]);
                    *(pg8::u32x4*)(rowp + bj * HALF) = w; } }
    }
};
struct EpiGateF32 {
    static constexpr bool PERM = true;
    float* X; const bf16* GT;
    __device__ __forceinline__ void operator()(const f32x4 (&acc)[2][2][4][2], const Unit& u, int wr, int wc, int fr, int fq) const {
        const int row0 = u.pm * BM + wr * 64 + fr, col0 = u.pn * BM + wc * 32 + 8 * fq;
#pragma unroll
        for (int ai = 0; ai < 2; ++ai)
#pragma unroll
            for (int m = 0; m < 4; ++m) { const size_t ro = (size_t)(row0 + ai * HALF + m * 16) * D + col0;
#pragma unroll
                for (int bj = 0; bj < 2; ++bj) { const pg8::u32x4 gw = *(const pg8::u32x4*)(GT + ro + bj * HALF);
                    f32x4 v0 = acc[ai][bj][m][0], v1 = acc[ai][bj][m][1];
                    v0[0] *= bf_lo(gw.x); v0[1] *= bf_hi(gw.x); v0[2] *= bf_lo(gw.y); v0[3] *= bf_hi(gw.y);
                    v1[0] *= bf_lo(gw.z); v1[1] *= bf_hi(gw.z); v1[2] *= bf_lo(gw.w); v1[3] *= bf_hi(gw.w);
                    *(f32x4*)(X + ro + bj * HALF) = v0; *(f32x4*)(X + ro + bj * HALF + 4) = v1; } }
    }
};
struct EpiGateAddBf16 {
    static constexpr bool PERM = true;
    const float* X; const bf16* GT; bf16* O;
    __device__ __forceinline__ void operator()(const f32x4 (&acc)[2][2][4][2], const Unit& u, int wr, int wc, int fr, int fq) const {
        const int row0 = u.pm * BM + wr * 64 + fr, col0 = u.pn * BM + wc * 32 + 8 * fq;
#pragma unroll
        for (int ai = 0; ai < 2; ++ai)
#pragma unroll
            for (int m = 0; m < 4; ++m) { const size_t ro = (size_t)(row0 + ai * HALF + m * 16) * D + col0;
#pragma unroll
                for (int bj = 0; bj < 2; ++bj) { const pg8::u32x4 gw = *(const pg8::u32x4*)(GT + ro + bj * HALF);
                    const f32x4 x0 = *(const f32x4*)(X + ro + bj * HALF), x1 = *(const f32x4*)(X + ro + bj * HALF + 4);
                    f32x4 v0 = acc[ai][bj][m][0], v1 = acc[ai][bj][m][1];
                    v0[0] = x0[0] + v0[0] * bf_lo(gw.x); v0[1] = x0[1] + v0[1] * bf_hi(gw.x); v0[2] = x0[2] + v0[2] * bf_lo(gw.y); v0[3] = x0[3] + v0[3] * bf_hi(gw.y);
                    v1[0] = x1[0] + v1[0] * bf_lo(gw.z); v1[1] = x1[1] + v1[1] * bf_hi(gw.z); v1[2] = x1[2] + v1[2] * bf_lo(gw.w); v1[3] = x1[3] + v1[3] * bf_hi(gw.w);
                    pg8::u32x4 w; w.x = cvt_pk_bf16(v0[0], v0[1]); w.y = cvt_pk_bf16(v0[2], v0[3]); w.z = cvt_pk_bf16(v1[0], v1[1]); w.w = cvt_pk_bf16(v1[2], v1[3]);
                    *(pg8::u32x4*)(O + ro + bj * HALF) = w; } }
    }
};
template <bool WITH_HB> struct EpiResid {
    static constexpr bool PERM = true;
    const float* R; float* H; bf16* HB; const float* gain; float* SSQ;
    __device__ __forceinline__ void operator()(const f32x4 (&acc)[2][2][4][2], const Unit& u, int wr, int wc, int fr, int fq) const {
        const int row0 = u.pm * BM + wr * 64 + fr, col0 = u.pn * BM + wc * 32 + 8 * fq;
        f32x4 gv[2][2];
        if (WITH_HB) {
#pragma unroll
            for (int bj = 0; bj < 2; ++bj)
#pragma unroll
                for (int n = 0; n < 2; ++n) gv[bj][n] = *(const f32x4*)(gain + col0 + bj * HALF + 4 * n);
        }
#pragma unroll
        for (int ai = 0; ai < 2; ++ai)
#pragma unroll
            for (int m = 0; m < 4; ++m) { const int row = row0 + ai * HALF + m * 16; const size_t ro = (size_t)row * D + col0; float ss = 0.f;
#pragma unroll
                for (int bj = 0; bj < 2; ++bj) {
                    const f32x4 h0 = *(const f32x4*)(R + ro + bj * HALF) + acc[ai][bj][m][0], h1 = *(const f32x4*)(R + ro + bj * HALF + 4) + acc[ai][bj][m][1];
                    ss += (h0[0] * h0[0] + h0[1] * h0[1]) + (h0[2] * h0[2] + h0[3] * h0[3]) + (h1[0] * h1[0] + h1[1] * h1[1]) + (h1[2] * h1[2] + h1[3] * h1[3]);
                    *(f32x4*)(H + ro + bj * HALF) = h0; *(f32x4*)(H + ro + bj * HALF + 4) = h1;
                    if (WITH_HB) { const f32x4 a0 = h0 * gv[bj][0], a1 = h1 * gv[bj][1];
                        pg8::u32x4 w; w.x = cvt_pk_bf16(a0[0], a0[1]); w.y = cvt_pk_bf16(a0[2], a0[3]); w.z = cvt_pk_bf16(a1[0], a1[1]); w.w = cvt_pk_bf16(a1[2], a1[3]);
                        *(pg8::u32x4*)(HB + ro + bj * HALF) = w; }
                }
                ss += __shfl_xor(ss, 16); ss += __shfl_xor(ss, 32);
                if (fq == 0) SSQ[(size_t)(u.pn * 4 + wc) * T + row] = ss;
            }
    }
};
struct EpiSwiGLU {
    static constexpr bool PERM = true;
    bf16* O; const float* RS;
    __device__ __forceinline__ void operator()(const f32x4 (&acc)[2][2][4][2], const Unit& u, int wr, int wc, int fr, int fq) const {
        const int row0 = u.pm * BM + wr * 64 + fr, col0 = u.pn * HALF + wc * 32 + 8 * fq;
#pragma unroll
        for (int ai = 0; ai < 2; ++ai)
#pragma unroll
            for (int m = 0; m < 4; ++m) { const int row = row0 + ai * HALF + m * 16; const float r = RS[row];
                float o[8];
#pragma unroll
                for (int n = 0; n < 2; ++n)
#pragma unroll
                    for (int j = 0; j < 4; ++j) { const float gt = acc[ai][0][m][n][j] * r, up = acc[ai][1][m][n][j] * r; o[4 * n + j] = fsilu(gt) * up; }
                pg8::u32x4 w; w.x = cvt_pk_bf16(o[0], o[1]); w.y = cvt_pk_bf16(o[2], o[3]); w.z = cvt_pk_bf16(o[4], o[5]); w.w = cvt_pk_bf16(o[6], o[7]);
                *(pg8::u32x4*)(O + (size_t)row * DFF + col0) = w; }
    }
};

struct Frame {
    LAS unsigned char* lds;
    volatile LAS unsigned* MISC;
    gu32* ctl;
    int tid, lane, wave;
    int vcu, G;
};
__device__ __forceinline__ float wave_sum(float v) {
#pragma unroll
    for (int o = 1; o < 64; o <<= 1) v += __shfl_xor(v, o);
    return v;
}
__device__ __forceinline__ void p0_transpose_item(const float* W, int N, bf16* WT, int ldt, int rowmode, LAS float* scr, int kb, int nb, int lane) {
    const int k0 = 64 * kb, n0 = 32 * nb;
    const int lk = lane >> 3, ln = (lane & 7) * 4;
#pragma unroll
    for (int i = 0; i < 8; ++i) { const int kk = 8 * i + lk; const f32x4 v = *(const GAS f32x4*)(W + (size_t)(k0 + kk) * N + n0 + ln);
        scr[kk * 33 + ln] = v[0]; scr[kk * 33 + ln + 1] = v[1]; scr[kk * 33 + ln + 2] = v[2]; scr[kk * 33 + ln + 3] = v[3]; }
    LDS_WAIT(); asm volatile("" ::: "memory");
    const int c = lane & 7;
#pragma unroll
    for (int j = 0; j < 4; ++j) { const int n = (lane >> 3) + 8 * j; const LAS float* s = scr + (8 * c) * 33 + n;
        v4u o; o.x = pk2(s[0 * 33], s[1 * 33]); o.y = pk2(s[2 * 33], s[3 * 33]); o.z = pk2(s[4 * 33], s[5 * 33]); o.w = pk2(s[6 * 33], s[7 * 33]);
        const int ng = n0 + n; const int row = rowmode == 0 ? ng : ((ng >> 7) * 256 + (rowmode == 2 ? 128 : 0) + (ng & 127));
        *(GAS v4u*)(WT + (size_t)row * ldt + k0 + 8 * c) = o; }
    LDS_WAIT(); asm volatile("" ::: "memory");
}
__device__ __forceinline__ void p0_transpose_matrix(const float* W, int K, int N, bf16* WT, int ldt, int rowmode, LAS float* scr, int gw, int NGW, int lane) {
    const int nblk = N / 32, nitems = (K / 64) * nblk;
    for (int it = gw; it < nitems; it += NGW) p0_transpose_item(W, N, WT, ldt, rowmode, scr, it / nblk, it % nblk, lane);
}

struct Args { const float* in[15]; float* out; unsigned char* ws; int ph_lo, ph_hi, li, pad; };

__global__ void __launch_bounds__(NWAVES * 64, 2) fwd(Args args) {
    extern __shared__ __attribute__((aligned(16))) unsigned char lds[];
    Frame F;
    F.lds = (LAS unsigned char*)lds;
    F.MISC = (volatile LAS unsigned*)(F.lds + MISC_OFF);
    F.tid = threadIdx.x; F.lane = F.tid & 63; F.wave = __builtin_amdgcn_readfirstlane(F.tid >> 6);
    F.G = gridDim.x; { const int bx = blockIdx.x; F.vcu = (F.G % 8 == 0) ? (bx % 8) * (F.G / 8) + bx / 8 : bx; }
    unsigned char* ws = args.ws;
    F.ctl = (gu32*)(ws + WS_CTL);
    const float* x = args.in[0]; const float* g_mix = args.in[1]; const float* w_in = args.in[2]; const float* w_pg = args.in[3]; const float* pool_scale = args.in[4];
    const float* lb_param = args.in[5]; const float* hgrn_norm = args.in[6]; const float* w_up_pool = args.in[7]; const float* w_up_hgrn = args.in[8]; const float* w_out = args.in[9];
    const float* g_ffn = args.in[10]; const float* w_gate = args.in[11]; const float* w_up = args.in[12]; const float* w_down = args.in[13]; const float* g_final = args.in[14];
    float* out = args.out;
    bf16* WinT = (bf16*)(ws + WS_WIN); bf16* WpgT = (bf16*)(ws + WS_WPG); bf16* WupT = (bf16*)(ws + WS_WUP); bf16* WuhT = (bf16*)(ws + WS_WUH); bf16* WoT = (bf16*)(ws + WS_WO);
    bf16* WguT = (bf16*)(ws + WS_WGU); bf16* WdT = (bf16*)(ws + WS_WD);
    bf16* U = (bf16*)(ws + WS_U); bf16* MG = U;
    bf16* Zb = (bf16*)(ws + WS_Z); bf16* QSb = (bf16*)(ws + WS_QS); bf16* Gb = (bf16*)(ws + WS_G); bf16* KKb = (bf16*)(ws + WS_KK); bf16* Vb = (bf16*)(ws + WS_V); bf16* OGb = (bf16*)(ws + WS_OG);
    bf16* GAb = (bf16*)(ws + WS_GA); bf16* GBb = (bf16*)(ws + WS_GB); bf16* ACT = (bf16*)(ws + WS_ACT);
    bf16* Pb = (bf16*)(ws + WS_P); bf16* YP = (bf16*)(ws + WS_YP); bf16* YH = (bf16*)(ws + WS_YH); bf16* H1B = (bf16*)(ws + WS_H1B);
    float* Obuf = (float*)(ws + WS_O); float* SSQ1 = (float*)(ws + WS_SSQ1); float* SSQ2 = (float*)(ws + WS_SSQ2); float* RS1 = (float*)(ws + WS_RS1);

    for (int u = F.tid; u < (LDS_BYTES - LDSCTL_OFF) / 4; u += NWAVES * 64) ((LAS unsigned*)(F.lds + LDSCTL_OFF))[u] = 0u;
    __syncthreads();
    XcdBarrier bar; bar.bar = (unsigned*)(F.ctl + 4096); bar.x = 0; bar.st = nullptr;
    if (N_LAUNCHES == 1) bar = xcd_barrier_post((unsigned*)(F.ctl + 4096), F.MISC + 8);
#define GRID_BAR() do { if (N_LAUNCHES == 1) xcd_barrier(bar); } while (0)
    const int lo = args.ph_lo, hi = args.ph_hi;
#define IN(k) (lo <= (k) && (k) < hi)
#define BOTH(k) (IN(k) && IN((k) + 1))
    const int gw = F.vcu * NWAVES + F.wave, NGW = F.G * NWAVES;
    const int gt = F.vcu * (NWAVES * 64) + F.tid, NGT = F.G * NWAVES * 64;

    if (IN(0)) {
        LAS float* scr = (LAS float*)(F.lds + RING_OFF + F.wave * 16384);
        p0_transpose_matrix(w_in, D, NIN, WinT, D, 0, scr, gw, NGW, F.lane);
#pragma unroll 1
        for (int gi = 0; gi < 4; ++gi) p0_transpose_matrix(w_pg + (size_t)gi * 512 * 512, 512, 512, WpgT + (size_t)gi * 512 * 512, 512, 0, scr, gw, NGW, F.lane);
        p0_transpose_matrix(w_up_pool, PW, D, WupT, PW, 0, scr, gw, NGW, F.lane);
        p0_transpose_matrix(w_up_hgrn, HW, D, WuhT, HW, 0, scr, gw, NGW, F.lane);
        p0_transpose_matrix(w_out, D, D, WoT, D, 0, scr, gw, NGW, F.lane);
        p0_transpose_matrix(w_gate, D, DFF, WguT, D, 1, scr, gw, NGW, F.lane);
        p0_transpose_matrix(w_up, D, DFF, WguT, D, 2, scr, gw, NGW, F.lane);
        p0_transpose_matrix(w_down, DFF, D, WdT, DFF, 0, scr, gw, NGW, F.lane);
        for (int m = gw; m < T; m += NGW) {
            const GAS f32x4* xr = (const GAS f32x4*)(x + (size_t)m * D) + F.lane; const GAS f32x4* gr = (const GAS f32x4*)g_mix + F.lane;
            f32x4 v[16]; float s = 0.f;
#pragma unroll
            for (int j = 0; j < 16; ++j) { v[j] = xr[64 * j]; s += (v[j][0] * v[j][0] + v[j][1] * v[j][1]) + (v[j][2] * v[j][2] + v[j][3] * v[j][3]); }
            const float r = 1.0f / sqrtf(wave_sum(s) * (1.0f / D) + EPS);
            GAS v2u* o8 = (GAS v2u*)(U + (size_t)m * D) + F.lane;
#pragma unroll
            for (int j = 0; j < 16; ++j) { const f32x4 gg = gr[64 * j]; v2u w; w.x = pk2(v[j][0] * r * gg[0], v[j][1] * r * gg[1]); w.y = pk2(v[j][2] * r * gg[2], v[j][3] * r * gg[3]); o8[64 * j] = w; }
        }
        if (BOTH(0)) GRID_BAR();
    }
    if (IN(1)) {
        pg8::Gemm g{U, WinT, T, NIN, D, D, D, 0, 0}; pg8::StaticOrder S; S.init(T, NIN, F.G, (int)blockIdx.x);
        EpiProj E{Zb, lb_param};
        pg8::gemm_phase<EpiProj, pg8::StaticOrder, true, true>(F.lds + RING_OFF, g, S, E);
        if (BOTH(1)) GRID_BAR();
    }
    if (IN(2)) {
        for (int it = gt; it < T * (PW / 8); it += NGT) {
            const int t = it >> 8, c8 = (it & 255) * 8; const int w = 2 << (c8 >> 9); const int cnt = (t + 1 < w) ? t + 1 : w;
            float s[8], z0[8];
#pragma unroll
            for (int j = 0; j < 8; ++j) s[j] = 0.f;
            for (int d = 0; d < cnt; ++d) { const v4u q = *(const GAS v4u*)(Zb + (size_t)(t - d) * PW + c8);
                const float e[8] = {bf_lo(q.x), bf_hi(q.x), bf_lo(q.y), bf_hi(q.y), bf_lo(q.z), bf_hi(q.z), bf_lo(q.w), bf_hi(q.w)};
#pragma unroll
                for (int j = 0; j < 8; ++j) { s[j] += e[j]; if (d == 0) z0[j] = e[j]; } }
            const float inv = 1.0f / (float)cnt; v4u o;
            o.x = pk2(s[0] * inv - z0[0], s[1] * inv - z0[1]); o.y = pk2(s[2] * inv - z0[2], s[3] * inv - z0[3]); o.z = pk2(s[4] * inv - z0[4], s[5] * inv - z0[5]); o.w = pk2(s[6] * inv - z0[6], s[7] * inv - z0[7]);
            *(GAS v4u*)(Pb + (size_t)t * PW + c8) = o;
        }
        for (int b = F.vcu; b < NH * 16; b += F.G) {
            const int h = b >> 4, vg = b & 15; const int k = F.tid & 127, sub = F.tid >> 7; const int v0 = 8 * vg + 2 * sub;
            LAS float* part = (LAS float*)(F.lds + RING_OFF);
            float s0 = 0.f, s1 = 0.f;
            for (int t0 = 0; t0 < T; t0 += 64) {
#pragma unroll 1
                for (int tb = 0; tb < 64; tb += 16) {
                    float p0[16], p1[16];
#pragma unroll
                    for (int i = 0; i < 16; ++i) { const size_t ro = (size_t)(t0 + tb + i) * HW + h * HD;
                        const float f = __expf(bf2f(Gb[ro + k])), kk = bf2f(KKb[ro + k]), q = bf2f(QSb[ro + k]); const float va = bf2f(Vb[ro + v0]), vb = bf2f(Vb[ro + v0 + 1]);
                        s0 = f * s0 + kk * va; s1 = f * s1 + kk * vb; p0[i] = q * s0; p1[i] = q * s1; }
#pragma unroll
                    for (int o = 1; o < 64; o <<= 1) {
#pragma unroll
                        for (int i = 0; i < 16; ++i) { p0[i] += __shfl_xor(p0[i], o); p1[i] += __shfl_xor(p1[i], o); } }
                    if (F.lane == 0) {
#pragma unroll
                        for (int i = 0; i < 16; ++i) { part[((tb + i) * 8 + F.wave) * 2] = p0[i]; part[((tb + i) * 8 + F.wave) * 2 + 1] = p1[i]; } }
                }
                __syncthreads();
                { const int tl = F.tid >> 3, j = F.tid & 7, sb = j >> 1, c = j & 1;
                  const float o = part[(tl * 8 + 2 * sb) * 2 + c] + part[(tl * 8 + 2 * sb + 1) * 2 + c];
                  Obuf[(size_t)(t0 + tl) * HW + h * HD + 8 * vg + j] = o; }
                __syncthreads();
            }
        }
        if (BOTH(2)) GRID_BAR();
    }
    if (IN(3)) {
        pg8::Gemm g{Pb, WpgT, T, PW, 512, PW, 512, 1, 512}; pg8::StaticOrder S; S.init(T, PW, F.G, (int)blockIdx.x);
        EpiScaleBf16 E{YP, PW, pool_scale};
        pg8::gemm_phase<EpiScaleBf16, pg8::StaticOrder, true, true>(F.lds + RING_OFF, g, S, E);
        for (int it = gw; it < T * NH; it += NGW) {
            const int t = it >> 4, h = it & 15; const size_t off = (size_t)t * HW + h * HD + 2 * F.lane;
            const float o0 = Obuf[off], o1 = Obuf[off + 1];
            const float r = 1.0f / sqrtf(wave_sum(o0 * o0 + o1 * o1) * (1.0f / HD) + EPS);
            const unsigned gwd = *(const GAS unsigned*)(OGb + off);
            const float y0 = o0 * r * hgrn_norm[h * HD + 2 * F.lane] * bf_lo(gwd), y1 = o1 * r * hgrn_norm[h * HD + 2 * F.lane + 1] * bf_hi(gwd);
            *(GAS unsigned*)(YH + off) = pk2(y0, y1);
        }
        if (BOTH(3)) GRID_BAR();
    }
    if (IN(4)) {
        { pg8::Gemm g{YP, WupT, T, D, PW, PW, PW, 0, 0}; pg8::StaticOrder S; S.init(T, D, F.G, (int)blockIdx.x);
          EpiGateF32 E{out, GAb};
          pg8::gemm_phase<EpiGateF32, pg8::StaticOrder, true, true>(F.lds + RING_OFF, g, S, E); }
        { pg8::Gemm g{YH, WuhT, T, D, HW, HW, HW, 0, 0}; pg8::StaticOrder S; S.init(T, D, F.G, (int)blockIdx.x);
          EpiGateAddBf16 E{out, GBb, MG};
          pg8::gemm_phase<EpiGateAddBf16, pg8::StaticOrder, true, true>(F.lds + RING_OFF, g, S, E); }
        if (BOTH(4)) GRID_BAR();
    }
    if (IN(5)) {
        pg8::Gemm g{MG, WoT, T, D, D, D, D, 0, 0}; pg8::StaticOrder S; S.init(T, D, F.G, (int)blockIdx.x);
        EpiResid<true> E{x, out, H1B, g_ffn, SSQ1};
        pg8::gemm_phase<EpiResid<true>, pg8::StaticOrder, true, true>(F.lds + RING_OFF, g, S, E);
        if (BOTH(5)) GRID_BAR();
    }
    if (IN(6)) {
        for (int r = gt; r < T; r += NGT) { float s = 0.f;
#pragma unroll 8
            for (int p = 0; p < 64; ++p) s += SSQ1[(size_t)p * T + r];
            RS1[r] = 1.0f / sqrtf(s * (1.0f / D) + EPS); }
        if (BOTH(6)) GRID_BAR();
    }
    if (IN(7)) {
        pg8::Gemm g{H1B, WguT, T, 2 * DFF, D, D, D, 0, 0}; pg8::StaticOrder S; S.init(T, 2 * DFF, F.G, (int)blockIdx.x);
        EpiSwiGLU E{ACT, RS1};
        pg8::gemm_phase<EpiSwiGLU, pg8::StaticOrder, true, true>(F.lds + RING_OFF, g, S, E);
        if (BOTH(7)) GRID_BAR();
    }
    if (IN(8)) {
        pg8::Gemm g{ACT, WdT, T, D, DFF, DFF, DFF, 0, 0}; pg8::StaticOrder S; S.init(T, D, F.G, (int)blockIdx.x);
        EpiResid<false> E{out, out, nullptr, nullptr, SSQ2};
        pg8::gemm_phase<EpiResid<false>, pg8::StaticOrder, true, true>(F.lds + RING_OFF, g, S, E);
        if (BOTH(8)) GRID_BAR();
    }
    if (IN(9)) {
        for (int m = gw; m < T; m += NGW) {
            const float r = 1.0f / sqrtf(wave_sum(SSQ2[(size_t)F.lane * T + m]) * (1.0f / D) + EPS);
            GAS f32x4* orow = (GAS f32x4*)(out + (size_t)m * D) + F.lane; const GAS f32x4* gr = (const GAS f32x4*)g_final + F.lane;
#pragma unroll
            for (int j = 0; j < 16; ++j) { const f32x4 v = orow[64 * j]; const f32x4 gg = gr[64 * j]; orow[64 * j] = v * r * gg; }
        }
    }
#undef IN
#undef BOTH
#undef GRID_BAR
}

extern "C" void kernel_launch(void* const* d_in, const int* in_sizes, int n_in, void* d_out, int out_size, void* d_ws, size_t ws_size, hipStream_t stream) {
    static int grid = 0;
    if (grid == 0) {
        if (n_in != 15 || in_sizes[0] != T * D || out_size != T * D || ws_size < WS_END) { fprintf(stderr, "kernel_launch: unexpected shapes: n_in %d in0 %d out %d ws %zu (need %zu)\n", n_in, n_in > 0 ? in_sizes[0] : -1, out_size, ws_size, (size_t)WS_END); grid = -1; return; }
        int dev = 0, cus = 0, per_cu = 0;
        if (hipGetDevice(&dev) != hipSuccess || hipDeviceGetAttribute(&cus, hipDeviceAttributeMultiprocessorCount, dev) != hipSuccess) { grid = -1; return; }
        if (hipFuncSetAttribute((const void*)fwd, hipFuncAttributeMaxDynamicSharedMemorySize, LDS_BYTES) != hipSuccess) { fprintf(stderr, "kernel_launch: hipFuncSetAttribute failed\n"); grid = -1; return; }
        if (hipOccupancyMaxActiveBlocksPerMultiprocessor(&per_cu, (const void*)fwd, NWAVES * 64, LDS_BYTES) != hipSuccess || per_cu < 1) fprintf(stderr, "kernel_launch: occupancy query says %d\n", per_cu);
        (void)hipGetLastError();
        grid = cus;
    }
    if (grid < 0) return;
    if (hipMemsetAsync((char*)d_ws + WS_CTL, 0, CTL_ZERO_BYTES, stream) != hipSuccess) return;
    Args a{};
    for (int i = 0; i < 15; ++i) a.in[i] = (const float*)d_in[i];
    a.out = (float*)d_out; a.ws = (unsigned char*)d_ws;
    for (int li = 0; li < N_LAUNCHES; ++li) {
        a.ph_lo = (N_LAUNCHES == NPHASE) ? li : 0; a.ph_hi = (N_LAUNCHES == NPHASE) ? li + 1 : NPHASE; a.li = li;
        hipLaunchKernelGGL(fwd, dim3(grid), dim3(NWAVES * 64), LDS_BYTES, stream, a);
        const hipError_t le = hipPeekAtLastError();
        if (le != hipSuccess) { fprintf(stderr, "kernel_launch: launch %d failed: %s\n", li, hipGetErrorName(le)); break; }
    }
}
```

```cpp
#include <hip/hip_runtime.h>
#include <cstdio>
#include <cstdint>

#ifndef PROBE_DUP
#define PROBE_DUP -1
#endif
#ifndef MK_N_LAUNCHES
#define MK_N_LAUNCHES 1
#endif

namespace pg8 {
#define PG8_LAS __attribute__((address_space(3)))
typedef unsigned short bf16_t;
typedef short bf16x8 __attribute__((ext_vector_type(8)));
typedef float f32x4 __attribute__((ext_vector_type(4)));
typedef unsigned u32x4 __attribute__((ext_vector_type(4)));
typedef unsigned u32x2 __attribute__((ext_vector_type(2)));
constexpr int BM = 256, BK = 64, HALF = 128, HTB = HALF * BK * 2  , STAGE_BYTES = 8 * HTB, NXCD = 8, WGM = 8;

__host__ __device__ __forceinline__ int lds_byte(int r, int c) { const int st = (r >> 4) * 2 + (c >> 5), rr = r & 15, cc = c & 31, ob = rr * 64 + cc * 2; return st * 1024 + (ob ^ (((ob >> 9) & 1) << 5)); }
__host__ __device__ __forceinline__ void stage_rc(int b, int& R, int& C) { const int st = b / 1024, sb = b % 1024, swz = sb ^ (((sb >> 9) & 1) << 5); R = (st >> 1) * 16 + swz / 64; C = (st & 1) * 32 + (swz % 64) / 2; }
__host__ __device__ __forceinline__ int perm32(int rho) { const int n = rho >> 4, i = rho & 15; return 8 * (i >> 2) + 4 * n + (i & 3); }

struct Unit { int pm, pn; };
struct Gemm { const bf16_t* A; const bf16_t* Bt; int M, N, K, lda, ldb, agrp_shift, agrp_stride; };

struct StaticOrder {
    int nM, nN, nwg, G, c;
    __host__ __device__ void init(int M, int N, int G_, int c_) { nM = M / BM; nN = N / BM; nwg = nM * nN; G = G_; c = c_; }
    __host__ __device__ bool next(int i, Unit& u) const {
        const long L = (long)i * G + c; if (L >= nwg) return false;
        int wgid = (int)L; { const int q = nwg / NXCD, r = nwg % NXCD, xcd = wgid % NXCD, off = wgid / NXCD; wgid = (xcd < r ? xcd * (q + 1) : r * (q + 1) + (xcd - r) * q) + off; }
        const int nig = WGM * nN, gid = wgid / nig, fm = gid * WGM, gsz = (nM - fm) < WGM ? (nM - fm) : WGM;
        u.pm = fm + ((wgid % nig) % gsz); u.pn = (wgid % nig) / gsz; return true;
    }
    __device__ __forceinline__ void a_ready(const Unit&) const {}
    __device__ __forceinline__ void done(const Unit&) const {}
};

__device__ __forceinline__ unsigned cvt_pk_bf16(float lo, float hi) { unsigned r; asm volatile("v_cvt_pk_bf16_f32 %0, %1, %2" : "=v"(r) : "v"(lo), "v"(hi)); return r; }
__device__ __forceinline__ float bf_lo(unsigned w) { return __uint_as_float(w << 16); }
__device__ __forceinline__ float bf_hi(unsigned w) { return __uint_as_float(w & 0xffff0000u); }
__device__ __forceinline__ float fsigmoid(float x) { return __builtin_amdgcn_rcpf(1.0f + __expf(-x)); }
__device__ __forceinline__ float fsilu(float x) { return x * fsigmoid(x); }

template <class Epi, class Sched, bool ALIGN_EPI = false, bool SP2 = false>
__device__ __forceinline__ void gemm_phase(PG8_LAS unsigned char* lds, const Gemm g, const Sched& S, const Epi& E) {
    const int tid = threadIdx.x, wid = __builtin_amdgcn_readfirstlane(tid >> 6), lane = tid & 63, wr = wid >> 2, wc = wid & 3, fr = lane & 15, fq = lane >> 4;
    const int K = g.K, nt = K / BK;
    unsigned voffA[2], voffB[2];
#pragma unroll
    for (int i = 0; i < 2; ++i) { int R, C; stage_rc(tid * 16 + i * 8192, R, C); const int Rb = Epi::PERM ? ((R & ~31) + perm32(R & 31)) : R;
        voffA[i] = (unsigned)(R * g.lda + C) * 2u; voffB[i] = (unsigned)(Rb * g.ldb + C) * 2u; }
    const size_t kstep = (size_t)(BK * 2);
    const size_t hstepA = (size_t)HALF * g.lda * 2, hstepB = (size_t)HALF * g.ldb * 2;
    const size_t tstepA = 2 * hstepA, tstepB = 2 * hstepB;
    const unsigned ldsw = (unsigned)wid * 1024u;
    const int aoff = lds_byte(wr * 64 + fr, fq * 8), boff = lds_byte(wc * 32 + fr, fq * 8);
#define PG8_SA(b, h) (((b) * 2 + (h)) * HTB)
#define PG8_SB(b, h) ((4 + (b) * 2 + (h)) * HTB)
#define PG8_STAGE(bufoff, gbase, voff) do { _Pragma("unroll") for (int _i = 0; _i < 2; ++_i) \
        __builtin_amdgcn_global_load_lds((const unsigned*)((const char*)(gbase) + (voff)[_i]), (PG8_LAS unsigned*)(lds + (bufoff) + ldsw + _i * 8192), 16, 0, 0); } while (0)
#define PG8_LDA(dst, b, h) do { _Pragma("unroll") for (int m = 0; m < 4; ++m) _Pragma("unroll") for (int k = 0; k < 2; ++k) dst[m][k] = *(const PG8_LAS bf16x8*)(lds + PG8_SA(b, h) + aoff + m * 2048 + k * 1024); } while (0)
#define PG8_LDB(dst, b, h) do { _Pragma("unroll") for (int n = 0; n < 2; ++n) _Pragma("unroll") for (int k = 0; k < 2; ++k) dst[n][k] = *(const PG8_LAS bf16x8*)(lds + PG8_SB(b, h) + boff + n * 2048 + k * 1024); } while (0)
#define PG8_MMA(ai, bj, At, Bt) do { __builtin_amdgcn_s_setprio(1); _Pragma("unroll") for (int m = 0; m < 4; ++m) _Pragma("unroll") for (int n = 0; n < 2; ++n) _Pragma("unroll") for (int k = 0; k < 2; ++k) \
        acc[ai][bj][m][n] = __builtin_amdgcn_mfma_f32_16x16x32_bf16(Bt[n][k], At[m][k], acc[ai][bj][m][n], 0, 0, 0); __builtin_amdgcn_s_setprio(0); } while (0)
#define PG8_WAIT_V(n) asm volatile("s_waitcnt vmcnt(" #n ")" ::: "memory")
#define PG8_WAIT_L(n) asm volatile("s_waitcnt lgkmcnt(" #n ")" ::: "memory")
#define PG8_BAR __builtin_amdgcn_s_barrier()
#define PG8_SCHED __builtin_amdgcn_sched_barrier(0)
#define PG8_ABASE(u) ((const char*)g.A + (size_t)(u).pm * tstepA + (g.agrp_stride ? (size_t)(((u).pn >> g.agrp_shift) * g.agrp_stride) * 2 : (size_t)0))
    Unit cur, nxt; int ui = 0;
    if (!S.next(0, cur)) return;
    f32x4 acc[2][2][4][2];
#pragma unroll
    for (int a = 0; a < 2; ++a)
#pragma unroll
        for (int b = 0; b < 2; ++b)
#pragma unroll
            for (int m = 0; m < 4; ++m)
#pragma unroll
                for (int n = 0; n < 2; ++n) acc[a][b][m][n] = (f32x4){0.f, 0.f, 0.f, 0.f};
    bf16x8 At[4][2], B0[2][2], B1[2][2];
    const char* cA = PG8_ABASE(cur); const char* cB = (const char*)g.Bt + (size_t)cur.pn * tstepB;
    S.a_ready(cur);
    if constexpr (SP2) {
        PG8_STAGE(PG8_SB(0, 0), cB, voffB); PG8_STAGE(PG8_SB(0, 1), cB + hstepB, voffB); PG8_STAGE(PG8_SA(0, 0), cA, voffA); PG8_STAGE(PG8_SA(0, 1), cA + hstepA, voffA);
        if (wr == 1) PG8_BAR;
        PG8_WAIT_V(2); PG8_BAR;
        PG8_STAGE(PG8_SB(1, 0), cB + kstep, voffB); PG8_STAGE(PG8_SA(1, 0), cA + kstep, voffA); PG8_STAGE(PG8_SB(1, 1), cB + hstepB + kstep, voffB);
        PG8_WAIT_V(6); PG8_BAR;
    } else {
        PG8_STAGE(PG8_SB(0, 0), cB, voffB); PG8_STAGE(PG8_SA(0, 0), cA, voffA); PG8_STAGE(PG8_SB(0, 1), cB + hstepB, voffB); PG8_STAGE(PG8_SA(0, 1), cA + hstepA, voffA);
        if (wr == 1) PG8_BAR;
        PG8_WAIT_V(4); PG8_BAR;
        PG8_STAGE(PG8_SB(1, 0), cB + kstep, voffB); PG8_STAGE(PG8_SA(1, 0), cA + kstep, voffA); PG8_STAGE(PG8_SB(1, 1), cB + hstepB + kstep, voffB);
        PG8_WAIT_V(6); PG8_BAR;
    }
    for (;;) {
        const bool has_next = S.next(ui + 1, nxt);
        const char* nA = has_next ? PG8_ABASE(nxt) : cA; const char* nB = has_next ? (const char*)g.Bt + (size_t)nxt.pn * tstepB : cB;
        for (int t = 0; t < nt; t += 2) {
            const bool last = (t == nt - 2);
            const char* a1 = cA + (size_t)(t + 1) * kstep;
            const char* a2 = last ? nA : cA + (size_t)(t + 2) * kstep; const char* b2 = last ? nB : cB + (size_t)(t + 2) * kstep;
            const char* a3 = a2 + kstep; const char* b3 = b2 + kstep;
            if (last && has_next) S.a_ready(nxt);
            if constexpr (SP2) {
            PG8_LDB(B0, 0, 0); PG8_LDB(B1, 0, 1); PG8_SCHED; PG8_LDA(At, 0, 0); PG8_STAGE(PG8_SA(1, 1), a1 + hstepA, voffA);
            PG8_WAIT_V(8); PG8_WAIT_L(0); PG8_BAR; PG8_MMA(0, 0, At, B0); PG8_MMA(0, 1, At, B1); PG8_BAR; PG8_SCHED;
            PG8_LDA(At, 0, 1); PG8_STAGE(PG8_SB(0, 0), b2, voffB); PG8_STAGE(PG8_SB(0, 1), b2 + hstepB, voffB); PG8_STAGE(PG8_SA(0, 0), a2, voffA);
            PG8_WAIT_V(8); PG8_WAIT_L(0); PG8_BAR; PG8_MMA(1, 0, At, B0); PG8_MMA(1, 1, At, B1); PG8_BAR; PG8_SCHED;
            PG8_LDB(B0, 1, 0); PG8_LDB(B1, 1, 1); PG8_SCHED; PG8_LDA(At, 1, 0); PG8_STAGE(PG8_SA(0, 1), a2 + hstepA, voffA);
            PG8_WAIT_V(8); PG8_WAIT_L(0); PG8_BAR; PG8_MMA(0, 0, At, B0); PG8_MMA(0, 1, At, B1); PG8_BAR; PG8_SCHED;
            PG8_LDA(At, 1, 1); PG8_STAGE(PG8_SB(1, 0), b3, voffB); PG8_STAGE(PG8_SB(1, 1), b3 + hstepB, voffB); PG8_STAGE(PG8_SA(1, 0), a3, voffA);
            PG8_WAIT_V(8); PG8_WAIT_L(0); PG8_BAR; PG8_MMA(1, 0, At, B0); PG8_MMA(1, 1, At, B1); PG8_BAR; PG8_SCHED;
            } else {
            PG8_LDB(B0, 0, 0); PG8_SCHED; PG8_LDA(At, 0, 0); PG8_STAGE(PG8_SA(1, 1), a1 + hstepA, voffA);
            PG8_WAIT_L(8); PG8_BAR; PG8_WAIT_L(0); PG8_MMA(0, 0, At, B0); PG8_BAR; PG8_SCHED;
            PG8_LDB(B1, 0, 1); PG8_STAGE(PG8_SB(0, 0), b2, voffB);
            PG8_BAR; PG8_WAIT_L(0); PG8_MMA(0, 1, At, B1); PG8_BAR;
            PG8_LDA(At, 0, 1); PG8_STAGE(PG8_SA(0, 0), a2, voffA);
            PG8_BAR; PG8_WAIT_L(0); PG8_MMA(1, 0, At, B0); PG8_BAR; PG8_SCHED;
            PG8_STAGE(PG8_SB(0, 1), b2 + hstepB, voffB);
            PG8_WAIT_V(6); PG8_BAR; PG8_MMA(1, 1, At, B1); PG8_BAR;
            PG8_LDB(B0, 1, 0); PG8_SCHED; PG8_LDA(At, 1, 0); PG8_STAGE(PG8_SA(0, 1), a2 + hstepA, voffA);
            PG8_WAIT_L(8); PG8_BAR; PG8_WAIT_L(0); PG8_MMA(0, 0, At, B0); PG8_BAR; PG8_SCHED;
            PG8_LDB(B1, 1, 1); PG8_STAGE(PG8_SB(1, 0), b3, voffB);
            PG8_BAR; PG8_WAIT_L(0); PG8_MMA(0, 1, At, B1); PG8_BAR;
            PG8_LDA(At, 1, 1); PG8_STAGE(PG8_SA(1, 0), a3, voffA);
            PG8_BAR; PG8_WAIT_L(0); PG8_MMA(1, 0, At, B0); PG8_BAR; PG8_SCHED;
            PG8_STAGE(PG8_SB(1, 1), b3 + hstepB, voffB);
            PG8_WAIT_V(6); PG8_BAR; PG8_MMA(1, 1, At, B1); PG8_BAR;
            }
        }
        if constexpr (ALIGN_EPI) { if (wr == 0) PG8_BAR; }
        E(acc, cur, wr, wc, fr, fq); S.done(cur);
        if (!has_next) break;
#pragma unroll
        for (int a = 0; a < 2; ++a)
#pragma unroll
            for (int b = 0; b < 2; ++b)
#pragma unroll
                for (int m = 0; m < 4; ++m)
#pragma unroll
                    for (int n = 0; n < 2; ++n) acc[a][b][m][n] = (f32x4){0.f, 0.f, 0.f, 0.f};
        cur = nxt; cA = nA; cB = nB; ++ui;
        if constexpr (ALIGN_EPI) { if (wr == 1) PG8_BAR; }
    }
    PG8_WAIT_V(0);
    if constexpr (!ALIGN_EPI) { if (wr == 0) PG8_BAR; }
    PG8_BAR;
#undef PG8_ABASE
#undef PG8_SA
#undef PG8_SB
#undef PG8_STAGE
#undef PG8_LDA
#undef PG8_LDB
#undef PG8_MMA
#undef PG8_WAIT_V
#undef PG8_WAIT_L
#undef PG8_BAR
#undef PG8_SCHED
}
}

constexpr int NWAVES = 8;
constexpr int T = 8192, D = 4096, PW = 2048, HW = 2048, NH = 16, HD = 128, DFF = 11008;
constexpr int NIN = PW + 4 * HW + 2 * D;
constexpr float EPS = 1e-6f;
constexpr int NPHASE = 11;
constexpr int N_LAUNCHES = MK_N_LAUNCHES;

constexpr size_t MiB = 1u << 20;
constexpr size_t WS_CTL = 0, CTL_ZERO_BYTES = 1 * MiB;
constexpr size_t WS_WIN = 1 * MiB;
constexpr size_t WS_WPG = WS_WIN + 144 * MiB;
constexpr size_t WS_WUP = WS_WPG + 2 * MiB;
constexpr size_t WS_WUH = WS_WUP + 16 * MiB;
constexpr size_t WS_WO = WS_WUH + 16 * MiB;
constexpr size_t WS_WGU = WS_WO + 32 * MiB;
constexpr size_t WS_WD = WS_WGU + 172 * MiB;
constexpr size_t WS_U = WS_WD + 86 * MiB;
constexpr size_t WS_PROJ = WS_U + 64 * MiB;
constexpr size_t WS_Z = WS_PROJ, WS_QS = WS_Z + 32 * MiB, WS_G = WS_QS + 32 * MiB, WS_KK = WS_G + 32 * MiB, WS_V = WS_KK + 32 * MiB, WS_OG = WS_V + 32 * MiB;
constexpr size_t WS_GA = WS_OG + 32 * MiB, WS_GB = WS_GA + 64 * MiB;
constexpr size_t WS_ACT = WS_PROJ;
constexpr size_t WS_P = WS_PROJ + 320 * MiB;
constexpr size_t WS_YP = WS_P + 32 * MiB, WS_YH = WS_YP + 32 * MiB;
constexpr size_t WS_H1B = WS_YH + 32 * MiB;
constexpr size_t WS_O = WS_H1B + 64 * MiB;
constexpr size_t WS_HU = WS_O, WS_HS = WS_O + 16 * MiB, WS_HD = WS_O + 32 * MiB;
constexpr size_t WS_SSQ1 = WS_O + 64 * MiB, WS_SSQ2 = WS_SSQ1 + 2 * MiB, WS_RS1 = WS_SSQ2 + 2 * MiB;
constexpr size_t WS_END = WS_RS1 + 1 * MiB;
static_assert(WS_ACT + (size_t)T * DFF * 2 <= WS_P, "ACT overlay fits the projection region");

constexpr int RING_OFF = 0, RING_BYTES = 131072;
constexpr int LDSCTL_OFF = RING_BYTES, MISC_OFF = LDSCTL_OFF + 320;
constexpr int LDS_BYTES = 147456;
static_assert(MISC_OFF + 128 <= LDS_BYTES, "LDS map");

#define GAS __attribute__((address_space(1)))
#define LAS __attribute__((address_space(3)))
typedef unsigned short bf16;
typedef unsigned v4u __attribute__((ext_vector_type(4)));
typedef unsigned v2u __attribute__((ext_vector_type(2)));
typedef float f32x4 __attribute__((ext_vector_type(4)));
typedef GAS unsigned gu32;
#define RLX_AGENT __ATOMIC_RELAXED, __HIP_MEMORY_SCOPE_AGENT
#define LDS_WAIT() asm volatile("s_waitcnt lgkmcnt(0)" ::: "memory")
#define VM_WAIT() asm volatile("s_waitcnt vmcnt(0)" ::: "memory")
__device__ __forceinline__ unsigned f2bf(float f) { unsigned u = __builtin_bit_cast(unsigned, f); return (u + 0x7fffu + ((u >> 16) & 1u)) >> 16; }
__device__ __forceinline__ unsigned pk2(float lo, float hi) { return f2bf(lo) | (f2bf(hi) << 16); }
__device__ __forceinline__ float bf2f(unsigned short b) { return __uint_as_float(((unsigned)b) << 16); }

#define XB_TMO      128
#define XB_XCNT(j)  (256  + 64 * (j))
#define XB_XSUB(j)  (1280 + 64 * (j))
#define XB_XGEN(j)  (2304 + 64 * (j))
#define XB_TOP      3328
#define XB_TOPGEN   3392
#define XCD_BAR_WORDS 3456
#define XB_SPIN_CAP (1u << 18)
__device__ __forceinline__ unsigned xb_ld(unsigned* p)              { return __hip_atomic_load(p, __ATOMIC_RELAXED, __HIP_MEMORY_SCOPE_AGENT); }
__device__ __forceinline__ unsigned xb_add(unsigned* p, unsigned v) { return __hip_atomic_fetch_add(p, v, __ATOMIC_RELAXED, __HIP_MEMORY_SCOPE_AGENT); }
__device__ __forceinline__ unsigned xb_xcc_id() { return (unsigned)__builtin_amdgcn_s_getreg((3 << 11) | 20) & 0xFu; }
#define XB_SPIN(cond, bar) do { unsigned _sp = 0; while (cond) { __builtin_amdgcn_s_sleep(1); \
    if ((++_sp & 255u) == 0u) { if (xb_ld(&(bar)[XB_TMO])) break; if (_sp > XB_SPIN_CAP) { atomicAdd(&(bar)[XB_TMO], 1u); break; } } } } while (0)
struct XcdBarrier { unsigned* bar; unsigned x; volatile LAS unsigned* st; };
__device__ __forceinline__ XcdBarrier xcd_barrier_post(unsigned* bar, volatile LAS unsigned* st) {
    XcdBarrier b; b.bar = bar; b.x = xb_xcc_id(); b.st = st;
    if (threadIdx.x == 0) (void)xb_add(&bar[XB_XCNT(b.x)], 1u);
    return b;
}
__device__ __forceinline__ void xcd_barrier_complete(unsigned* bar, unsigned x, unsigned& nloc, unsigned& nx) {
    const unsigned G = gridDim.x * gridDim.y * gridDim.z;
    unsigned sum, cnt, mine, sp = 0u;
    for (;;) {
        sum = 0u; cnt = 0u; mine = 0u;
#pragma unroll
        for (unsigned j = 0; j < 16; ++j) { const unsigned c = xb_ld(&bar[XB_XCNT(j)]); sum += c; cnt += (c > 0u) ? 1u : 0u; mine = (j == x) ? c : mine; }
        if (sum == G) break;
        __builtin_amdgcn_s_sleep(1);
        if ((++sp & 255u) == 0u) { if (xb_ld(&bar[XB_TMO])) break; if (sp > XB_SPIN_CAP) { atomicAdd(&bar[XB_TMO], 1u); break; } }
    }
    nloc = mine > 0u ? mine : 1u; nx = cnt > 0u ? cnt : 1u;
}
__device__ __forceinline__ void xcd_barrier(const XcdBarrier& b) {
    asm volatile("s_waitcnt vmcnt(0)" ::: "memory");
    __syncthreads();
    if (threadIdx.x == 0) {
        unsigned* bar = b.bar;
        __builtin_amdgcn_s_waitcnt(0);
        unsigned nloc = b.st[0], nx = b.st[1];
        if (nloc == 0u) { xcd_barrier_complete(bar, b.x, nloc, nx); b.st[0] = nloc; b.st[1] = nx; }
        const unsigned old = xb_add(&bar[XB_XSUB(b.x)], 1u);
        const unsigned gen = old / nloc;
        if (old + 1u == (gen + 1u) * nloc) {
            __builtin_amdgcn_fence(__ATOMIC_RELEASE, "agent");
            asm volatile("s_waitcnt vmcnt(0)" ::: "memory");
            const unsigned og = xb_add(&bar[XB_TOP], 1u);
            const unsigned tg = og / nx;
            if (og + 1u == (tg + 1u) * nx) xb_add(&bar[XB_TOPGEN], 1u);
            else XB_SPIN(xb_ld(&bar[XB_TOPGEN]) == tg, bar);
            __builtin_amdgcn_fence(__ATOMIC_ACQUIRE, "agent");
            xb_add(&bar[XB_XGEN(b.x)], 1u);
            asm volatile("s_waitcnt vmcnt(0)" ::: "memory");
        } else {
            XB_SPIN(xb_ld(&bar[XB_XGEN(b.x)]) == gen, bar);
            __builtin_amdgcn_fence(__ATOMIC_ACQUIRE, "agent");
            asm volatile("s_waitcnt vmcnt(0)" ::: "memory");
        }
    }
    __syncthreads();
}

using pg8::Unit; using pg8::cvt_pk_bf16; using pg8::fsigmoid; using pg8::fsilu; using pg8::bf_lo; using pg8::bf_hi;
constexpr int BM = 256, HALF = 128;

struct EpiProj {
    static constexpr bool PERM = true;
    bf16* PROJ; const float* lbp;
    __device__ __forceinline__ void operator()(const f32x4 (&acc)[2][2][4][2], const Unit& u, int wr, int wc, int fr, int fq) const {
        const int row0 = u.pm * BM + wr * 64 + fr; const int cls = u.pn >> 3;
        int ldc, colt; size_t toff;
        if (cls < 5) { ldc = 2048; colt = (u.pn & 7) * 256; toff = (size_t)(cls + (cls >= 3 ? 1 : 0)) * ((size_t)T * 2048); }
        else { ldc = 4096; colt = (u.pn - (cls < 7 ? 40 : 56)) * 256; toff = (size_t)6 * ((size_t)T * 2048) + (cls < 7 ? (size_t)0 : (size_t)T * 4096); }
        bf16* base = PROJ + toff; bf16* G = PROJ + (size_t)2 * T * 2048; bf16* KK = PROJ + (size_t)3 * T * 2048;
        const int col0 = colt + wc * 32 + 8 * fq;
        if (cls == 2) {
            float lb[2][8];
#pragma unroll
            for (int bj = 0; bj < 2; ++bj) {
                const f32x4 p0a = *(const f32x4*)(lbp + col0 + bj * HALF), p0b = *(const f32x4*)(lbp + col0 + bj * HALF + 4);
                const f32x4 p1a = *(const f32x4*)(lbp + HW + col0 + bj * HALF), p1b = *(const f32x4*)(lbp + HW + col0 + bj * HALF + 4);
#pragma unroll
                for (int j = 0; j < 4; ++j) { lb[bj][j] = __builtin_amdgcn_rcpf(1.0f + __expf(p1a[j] - p0a[j])); lb[bj][4 + j] = __builtin_amdgcn_rcpf(1.0f + __expf(p1b[j] - p0b[j])); }
            }
#pragma unroll
            for (int ai = 0; ai < 2; ++ai)
#pragma unroll
                for (int m = 0; m < 4; ++m) { const size_t ro = (size_t)(row0 + ai * HALF + m * 16) * 2048 + col0;
#pragma unroll
                    for (int bj = 0; bj < 2; ++bj) { float gl[8], kv[8];
#pragma unroll
                        for (int n = 0; n < 2; ++n)
#pragma unroll
                            for (int j = 0; j < 4; ++j) { const float x = fminf(fmaxf(acc[ai][bj][m][n][j], -80.f), 80.f); const float e = __expf(-x); const float sg = __builtin_amdgcn_rcpf(1.0f + e); const float l = lb[bj][4 * n + j];
                                const float f = l + (1.0f - l) * sg; gl[4 * n + j] = __logf(f); kv[4 * n + j] = (1.0f - l) * (e * sg); }
                        pg8::u32x4 w; w.x = cvt_pk_bf16(gl[0], gl[1]); w.y = cvt_pk_bf16(gl[2], gl[3]); w.z = cvt_pk_bf16(gl[4], gl[5]); w.w = cvt_pk_bf16(gl[6], gl[7]);
                        *(pg8::u32x4*)(G + ro + bj * HALF) = w;
                        w.x = cvt_pk_bf16(kv[0], kv[1]); w.y = cvt_pk_bf16(kv[2], kv[3]); w.z = cvt_pk_bf16(kv[4], kv[5]); w.w = cvt_pk_bf16(kv[6], kv[7]);
                        *(pg8::u32x4*)(KK + ro + bj * HALF) = w; } }
            return;
        }
        const int act = (cls == 0 || cls == 3) ? 0 : (cls == 1 || cls == 4) ? 1 : 2;
#pragma unroll
        for (int ai = 0; ai < 2; ++ai)
#pragma unroll
            for (int m = 0; m < 4; ++m) { bf16* rowp = base + (size_t)(row0 + ai * HALF + m * 16) * ldc + col0;
#pragma unroll
                for (int bj = 0; bj < 2; ++bj) { f32x4 v0 = acc[ai][bj][m][0], v1 = acc[ai][bj][m][1];
                    if (act != 0) {
#pragma unroll
                        for (int j = 0; j < 4; ++j) { const float s0 = fsigmoid(v0[j]), s1 = fsigmoid(v1[j]); v0[j] = act == 1 ? v0[j] * s0 : s0; v1[j] = act == 1 ? v1[j] * s1 : s1; } }
                    pg8::u32x4 w; w.x = cvt_pk_bf16(v0[0], v0[1]); w.y = cvt_pk_bf16(v0[2], v0[3]); w.z = cvt_pk_bf16(v1[0], v1[1]); w.w = cvt_pk_bf16(v1[2], v1[3]);
                    *(pg8::u32x4*)(rowp + bj * HALF) = w; } }
    }
};
struct EpiScaleBf16 {
    static constexpr bool PERM = true;
    bf16* O; int ldc; const float* scale;
    __device__ __forceinline__ void operator()(const f32x4 (&acc)[2][2][4][2], const Unit& u, int wr, int wc, int fr, int fq) const {
        const int row0 = u.pm * BM + wr * 64 + fr, col0 = u.pn * BM + wc * 32 + 8 * fq;
        f32x4 sv[2][2];
#pragma unroll
        for (int bj = 0; bj < 2; ++bj)
#pragma unroll
            for (int n = 0; n < 2; ++n) sv[bj][n] = *(const f32x4*)(scale + col0 + bj * HALF + 4 * n);
#pragma unroll
        for (int ai = 0; ai < 2; ++ai)
#pragma unroll
            for (int m = 0; m < 4; ++m) { bf16* rowp = O + (size_t)(row0 + ai * HALF + m * 16) * ldc + col0;
#pragma unroll
                for (int bj = 0; bj < 2; ++bj) { const f32x4 v0 = acc[ai][bj][m][0] * sv[bj][0], v1 = acc[ai][bj][m][1] * sv[bj][1];
                    pg8::u32x4 w; w.x = cvt_pk_bf16(v0[0], v0[1]); w.y = cvt_pk_bf16(v0[2], v0[3]); w.z = cvt_pk_bf16(v1[0], v1[1]); w.w = cvt_pk_bf16(v1[2], v1[3]);
                    *(pg8::u32x4*)(rowp + bj * HALF) = w; } }
    }
};
struct EpiGateF32 {
    static constexpr bool PERM = true;
    float* X; const bf16* GT;
    __device__ __forceinline__ void operator()(const f32x4 (&acc)[2][2][4][2], const Unit& u, int wr, int wc, int fr, int fq) const {
        const int row0 = u.pm * BM + wr * 64 + fr, col0 = u.pn * BM + wc * 32 + 8 * fq;
#pragma unroll
        for (int ai = 0; ai < 2; ++ai)
#pragma unroll
            for (int m = 0; m < 4; ++m) { const size_t ro = (size_t)(row0 + ai * HALF + m * 16) * D + col0;
#pragma unroll
                for (int bj = 0; bj < 2; ++bj) { const pg8::u32x4 gw = *(const pg8::u32x4*)(GT + ro + bj * HALF);
                    f32x4 v0 = acc[ai][bj][m][0], v1 = acc[ai][bj][m][1];
                    v0[0] *= bf_lo(gw.x); v0[1] *= bf_hi(gw.x); v0[2] *= bf_lo(gw.y); v0[3] *= bf_hi(gw.y);
                    v1[0] *= bf_lo(gw.z); v1[1] *= bf_hi(gw.z); v1[2] *= bf_lo(gw.w); v1[3] *= bf_hi(gw.w);
                    *(f32x4*)(X + ro + bj * HALF) = v0; *(f32x4*)(X + ro + bj * HALF + 4) = v1; } }
    }
};
struct EpiGateAddBf16 {
    static constexpr bool PERM = true;
    const float* X; const bf16* GT; bf16* O;
    __device__ __forceinline__ void operator()(const f32x4 (&acc)[2][2][4][2], const Unit& u, int wr, int wc, int fr, int fq) const {
        const int row0 = u.pm * BM + wr * 64 + fr, col0 = u.pn * BM + wc * 32 + 8 * fq;
#pragma unroll
        for (int ai = 0; ai < 2; ++ai)
#pragma unroll
            for (int m = 0; m < 4; ++m) { const size_t ro = (size_t)(row0 + ai * HALF + m * 16) * D + col0;
#pragma unroll
                for (int bj = 0; bj < 2; ++bj) { const pg8::u32x4 gw = *(const pg8::u32x4*)(GT + ro + bj * HALF);
                    const f32x4 x0 = *(const f32x4*)(X + ro + bj * HALF), x1 = *(const f32x4*)(X + ro + bj * HALF + 4);
                    f32x4 v0 = acc[ai][bj][m][0], v1 = acc[ai][bj][m][1];
                    v0[0] = x0[0] + v0[0] * bf_lo(gw.x); v0[1] = x0[1] + v0[1] * bf_hi(gw.x); v0[2] = x0[2] + v0[2] * bf_lo(gw.y); v0[3] = x0[3] + v0[3] * bf_hi(gw.y);
                    v1[0] = x1[0] + v1[0] * bf_lo(gw.z); v1[1] = x1[1] + v1[1] * bf_hi(gw.z); v1[2] = x1[2] + v1[2] * bf_lo(gw.w); v1[3] = x1[3] + v1[3] * bf_hi(gw.w);
                    pg8::u32x4 w; w.x = cvt_pk_bf16(v0[0], v0[1]); w.y = cvt_pk_bf16(v0[2], v0[3]); w.z = cvt_pk_bf16(v1[0], v1[1]); w.w = cvt_pk_bf16(v1[2], v1[3]);
                    *(pg8::u32x4*)(O + ro + bj * HALF) = w; } }
    }
};
template <bool WITH_HB> struct EpiResid {
    static constexpr bool PERM = true;
    const float* R; float* H; bf16* HB; const float* gain; float* SSQ;
    __device__ __forceinline__ void operator()(const f32x4 (&acc)[2][2][4][2], const Unit& u, int wr, int wc, int fr, int fq) const {
        const int row0 = u.pm * BM + wr * 64 + fr, col0 = u.pn * BM + wc * 32 + 8 * fq;
        f32x4 gv[2][2];
        if (WITH_HB) {
#pragma unroll
            for (int bj = 0; bj < 2; ++bj)
#pragma unroll
                for (int n = 0; n < 2; ++n) gv[bj][n] = *(const f32x4*)(gain + col0 + bj * HALF + 4 * n);
        }
#pragma unroll
        for (int ai = 0; ai < 2; ++ai)
#pragma unroll
            for (int m = 0; m < 4; ++m) { const int row = row0 + ai * HALF + m * 16; const size_t ro = (size_t)row * D + col0; float ss = 0.f;
#pragma unroll
                for (int bj = 0; bj < 2; ++bj) {
                    const f32x4 h0 = *(const f32x4*)(R + ro + bj * HALF) + acc[ai][bj][m][0], h1 = *(const f32x4*)(R + ro + bj * HALF + 4) + acc[ai][bj][m][1];
                    ss += (h0[0] * h0[0] + h0[1] * h0[1]) + (h0[2] * h0[2] + h0[3] * h0[3]) + (h1[0] * h1[0] + h1[1] * h1[1]) + (h1[2] * h1[2] + h1[3] * h1[3]);
                    *(f32x4*)(H + ro + bj * HALF) = h0; *(f32x4*)(H + ro + bj * HALF + 4) = h1;
                    if (WITH_HB) { const f32x4 a0 = h0 * gv[bj][0], a1 = h1 * gv[bj][1];
                        pg8::u32x4 w; w.x = cvt_pk_bf16(a0[0], a0[1]); w.y = cvt_pk_bf16(a0[2], a0[3]); w.z = cvt_pk_bf16(a1[0], a1[1]); w.w = cvt_pk_bf16(a1[2], a1[3]);
                        *(pg8::u32x4*)(HB + ro + bj * HALF) = w; }
                }
                ss += __shfl_xor(ss, 16); ss += __shfl_xor(ss, 32);
                if (fq == 0) SSQ[(size_t)(u.pn * 4 + wc) * T + row] = ss;
            }
    }
};
struct EpiSwiGLU {
    static constexpr bool PERM = true;
    bf16* O; const float* RS;
    __device__ __forceinline__ void operator()(const f32x4 (&acc)[2][2][4][2], const Unit& u, int wr, int wc, int fr, int fq) const {
        const int row0 = u.pm * BM + wr * 64 + fr, col0 = u.pn * HALF + wc * 32 + 8 * fq;
#pragma unroll
        for (int ai = 0; ai < 2; ++ai)
#pragma unroll
            for (int m = 0; m < 4; ++m) { const int row = row0 + ai * HALF + m * 16; const float r = RS[row];
                float o[8];
#pragma unroll
                for (int n = 0; n < 2; ++n)
#pragma unroll
                    for (int j = 0; j < 4; ++j) { const float gt = acc[ai][0][m][n][j] * r, up = acc[ai][1][m][n][j] * r; o[4 * n + j] = fsilu(gt) * up; }
                pg8::u32x4 w; w.x = cvt_pk_bf16(o[0], o[1]); w.y = cvt_pk_bf16(o[2], o[3]); w.z = cvt_pk_bf16(o[4], o[5]); w.w = cvt_pk_bf16(o[6], o[7]);
                *(pg8::u32x4*)(O + (size_t)row * DFF + col0) = w; }
    }
};

struct Frame {
    LAS unsigned char* lds;
    volatile LAS unsigned* MISC;
    gu32* ctl;
    int tid, lane, wave;
    int vcu, G;
};
__device__ __forceinline__ float wave_sum(float v) {
#pragma unroll
    for (int o = 1; o < 64; o <<= 1) v += __shfl_xor(v, o);
    return v;
}
__device__ __forceinline__ void p0_transpose_item(const float* W, int N, bf16* WT, int ldt, int rowmode, LAS float* scr, int kb, int nb, int lane) {
    const int k0 = 64 * kb, n0 = 32 * nb;
    const int lk = lane >> 3, ln = (lane & 7) * 4;
#pragma unroll
    for (int i = 0; i < 8; ++i) { const int kk = 8 * i + lk; const f32x4 v = *(const GAS f32x4*)(W + (size_t)(k0 + kk) * N + n0 + ln);
        scr[kk * 33 + ln] = v[0]; scr[kk * 33 + ln + 1] = v[1]; scr[kk * 33 + ln + 2] = v[2]; scr[kk * 33 + ln + 3] = v[3]; }
    LDS_WAIT(); asm volatile("" ::: "memory");
    const int c = lane & 7;
#pragma unroll
    for (int j = 0; j < 4; ++j) { const int n = (lane >> 3) + 8 * j; const LAS float* s = scr + (8 * c) * 33 + n;
        v4u o; o.x = pk2(s[0 * 33], s[1 * 33]); o.y = pk2(s[2 * 33], s[3 * 33]); o.z = pk2(s[4 * 33], s[5 * 33]); o.w = pk2(s[6 * 33], s[7 * 33]);
        const int ng = n0 + n; const int row = rowmode == 0 ? ng : ((ng >> 7) * 256 + (rowmode == 2 ? 128 : 0) + (ng & 127));
        *(GAS v4u*)(WT + (size_t)row * ldt + k0 + 8 * c) = o; }
    LDS_WAIT(); asm volatile("" ::: "memory");
}
__device__ __forceinline__ void p0_transpose_matrix(const float* W, int K, int N, bf16* WT, int ldt, int rowmode, LAS float* scr, int gw, int NGW, int lane) {
    const int nblk = N / 32, nitems = (K / 64) * nblk;
    for (int it = gw; it < nitems; it += NGW) p0_transpose_item(W, N, WT, ldt, rowmode, scr, it / nblk, it % nblk, lane);
}

constexpr int HG_QA = 0, HG_KA = HG_QA + 8704, HG_KDT = HG_KA + 8704, HG_VT = HG_KDT + 10240, HG_ST = HG_VT + 10240, HG_P = HG_ST + 34816, HG_OCT = HG_P + 2560, HG_DEC = HG_OCT + 2048, HG_SSQ = HG_DEC + 512, HG_END = HG_SSQ + 1024;
static_assert(HG_END <= RING_BYTES, "HGRN LDS map");
typedef short bf16x8_t __attribute__((ext_vector_type(8)));
template <bool FULL>
__device__ __forceinline__ void hgrn_pass(LAS unsigned char* lds, int h, int sc, const bf16* QS, const bf16* Gl, const bf16* KK, const bf16* Vv, const bf16* OG, const float* hnorm,
                                          float* Ubuf, float* Dtot, const float* Sin, bf16* YH, int tid, int lane, int w) {
    const int k = tid & 127, ro = tid >> 7, fr = lane & 15, q = lane >> 4;
    LAS bf16* QA = (LAS bf16*)(lds + HG_QA); LAS bf16* KA = (LAS bf16*)(lds + HG_KA); LAS bf16* KDT = (LAS bf16*)(lds + HG_KDT); LAS bf16* VT = (LAS bf16*)(lds + HG_VT);
    LAS bf16* ST = (LAS bf16*)(lds + HG_ST); LAS bf16* Pm = (LAS bf16*)(lds + HG_P); LAS float* OCT = (LAS float*)(lds + HG_OCT); LAS float* DEC = (LAS float*)(lds + HG_DEC); LAS float* SSQ = (LAS float*)(lds + HG_SSQ);
    const size_t item = (size_t)(h * 16 + sc);
    f32x4 S[8];
#pragma unroll
    for (int kb = 0; kb < 8; ++kb) {
        if (FULL) {
#pragma unroll
            for (int r = 0; r < 4; ++r) S[kb][r] = Sin[(item << 14) + (size_t)(16 * kb + 4 * q + r) * 128 + 16 * w + fr];
        } else S[kb] = (f32x4){0.f, 0.f, 0.f, 0.f};
    }
    if (FULL) { for (int i = tid; i < 32 * 40; i += 512) Pm[i] = 0; }
    const size_t cb = (size_t)h * HD;
    const int t00 = sc * 512;
    const float hn = FULL ? hnorm[h * HD + 16 * w + fr] : 0.f;
    float btot = 0.f;
    unsigned short cg[8], ck[8], cv[8], cq[8];
#pragma unroll
    for (int j = 0; j < 8; ++j) { const size_t ro_ = (size_t)(t00 + 8 * ro + j) * HW + cb + k; cg[j] = Gl[ro_]; ck[j] = KK[ro_]; cv[j] = Vv[ro_]; cq[j] = FULL ? QS[ro_] : (unsigned short)0; }
#pragma unroll 1
    for (int blk = 0; blk < 16; ++blk) {
        const int t0 = t00 + 32 * blk;
        unsigned short ng[8], nk[8], nv[8], nq[8], og[8];
        if (blk < 15) {
#pragma unroll
            for (int j = 0; j < 8; ++j) { const size_t ro_ = (size_t)(t0 + 32 + 8 * ro + j) * HW + cb + k; ng[j] = Gl[ro_]; nk[j] = KK[ro_]; nv[j] = Vv[ro_]; nq[j] = FULL ? QS[ro_] : (unsigned short)0; }
        } else {
#pragma unroll
            for (int j = 0; j < 8; ++j) { ng[j] = 0; nk[j] = 0; nv[j] = 0; nq[j] = 0; }
        }
        if (FULL) {
#pragma unroll
            for (int tb = 0; tb < 2; ++tb)
#pragma unroll
                for (int r = 0; r < 4; ++r) og[tb * 4 + r] = OG[(size_t)(t0 + 16 * tb + 4 * q + r) * HW + cb + 16 * w + fr];
        }
        float c[8]; c[0] = bf2f(cg[0]);
#pragma unroll
        for (int j = 1; j < 8; ++j) c[j] = c[j - 1] + bf2f(cg[j]);
        OCT[ro * 128 + k] = c[7];
        __syncthreads();
        const float o0 = OCT[k], o1 = OCT[128 + k], o2 = OCT[256 + k], o3 = OCT[384 + k];
        const float off = (ro > 0 ? o0 : 0.f) + (ro > 1 ? o1 : 0.f) + (ro > 2 ? o2 : 0.f); const float b32 = (o0 + o1) + (o2 + o3);
        btot += b32;
        { unsigned kdw[4], vw[4];
#pragma unroll
          for (int j = 0; j < 8; j += 2) {
              const float b0 = off + c[j], b1 = off + c[j + 1]; const float k0 = bf2f(ck[j]), k1 = bf2f(ck[j + 1]);
              kdw[j >> 1] = pk2(k0 * __expf(b32 - b0), k1 * __expf(b32 - b1)); vw[j >> 1] = (unsigned)cv[j] | ((unsigned)cv[j + 1] << 16);
              if (FULL) { const float e0 = __expf(b0), e1 = __expf(b1); const float i0 = __expf(fminf(-b0, 80.f)), i1 = __expf(fminf(-b1, 80.f));
                  QA[(8 * ro + j) * 136 + k] = (bf16)f2bf(bf2f(cq[j]) * e0); QA[(8 * ro + j + 1) * 136 + k] = (bf16)f2bf(bf2f(cq[j + 1]) * e1);
                  KA[(8 * ro + j) * 136 + k] = (bf16)f2bf(k0 * i0); KA[(8 * ro + j + 1) * 136 + k] = (bf16)f2bf(k1 * i1); }
          }
          *(LAS v4u*)(KDT + k * 40 + 8 * ro) = (v4u){kdw[0], kdw[1], kdw[2], kdw[3]};
          *(LAS v4u*)(VT + k * 40 + 8 * ro) = (v4u){vw[0], vw[1], vw[2], vw[3]}; }
        if (ro == 0) DEC[k] = __expf(b32);
        if (FULL) {
#pragma unroll
            for (int kb = 0; kb < 8; ++kb) { v2u wv; wv.x = pk2(S[kb][0], S[kb][1]); wv.y = pk2(S[kb][2], S[kb][3]); *(LAS v2u*)(ST + (16 * w + fr) * 136 + 16 * kb + 4 * q) = wv; }
        }
        __syncthreads();
        f32x4 oacc[2] = {(f32x4){0.f, 0.f, 0.f, 0.f}, (f32x4){0.f, 0.f, 0.f, 0.f}};
        const bf16x8_t bV = *(const LAS bf16x8_t*)(VT + (16 * w + fr) * 40 + 8 * q);
        if (FULL) {
            if (w < 3) {
                const int tb = w > 0 ? 1 : 0, sb = w > 1 ? 1 : 0; f32x4 pa = (f32x4){0.f, 0.f, 0.f, 0.f};
#pragma unroll
                for (int kk = 0; kk < 4; ++kk) { const bf16x8_t a = *(const LAS bf16x8_t*)(QA + (16 * tb + fr) * 136 + 32 * kk + 8 * q); const bf16x8_t b = *(const LAS bf16x8_t*)(KA + (16 * sb + fr) * 136 + 32 * kk + 8 * q);
                    pa = __builtin_amdgcn_mfma_f32_16x16x32_bf16(a, b, pa, 0, 0, 0); }
#pragma unroll
                for (int r = 0; r < 4; ++r) { const int t = 16 * tb + 4 * q + r, s_ = 16 * sb + fr; Pm[t * 40 + s_] = (bf16)f2bf(s_ <= t ? pa[r] : 0.f); }
            }
#pragma unroll
            for (int tb = 0; tb < 2; ++tb)
#pragma unroll
                for (int kk = 0; kk < 4; ++kk) { const bf16x8_t a = *(const LAS bf16x8_t*)(QA + (16 * tb + fr) * 136 + 32 * kk + 8 * q); const bf16x8_t b = *(const LAS bf16x8_t*)(ST + (16 * w + fr) * 136 + 32 * kk + 8 * q);
                    oacc[tb] = __builtin_amdgcn_mfma_f32_16x16x32_bf16(a, b, oacc[tb], 0, 0, 0); }
        }
#pragma unroll
        for (int kb = 0; kb < 8; ++kb) { const f32x4 d4 = *(const LAS f32x4*)(DEC + 16 * kb + 4 * q); const bf16x8_t a = *(const LAS bf16x8_t*)(KDT + (16 * kb + fr) * 40 + 8 * q);
            S[kb] = __builtin_amdgcn_mfma_f32_16x16x32_bf16(a, bV, S[kb] * d4, 0, 0, 0); }
        if (FULL) {
            __syncthreads();
#pragma unroll
            for (int tb = 0; tb < 2; ++tb) { const bf16x8_t a = *(const LAS bf16x8_t*)(Pm + (16 * tb + fr) * 40 + 8 * q); oacc[tb] = __builtin_amdgcn_mfma_f32_16x16x32_bf16(a, bV, oacc[tb], 0, 0, 0); }
#pragma unroll
            for (int tb = 0; tb < 2; ++tb)
#pragma unroll
                for (int r = 0; r < 4; ++r) { float ss = oacc[tb][r] * oacc[tb][r]; ss += __shfl_xor(ss, 1); ss += __shfl_xor(ss, 2); ss += __shfl_xor(ss, 4); ss += __shfl_xor(ss, 8);
                    if (fr == 0) SSQ[(16 * tb + 4 * q + r) * 8 + w] = ss; }
            __syncthreads();
#pragma unroll
            for (int tb = 0; tb < 2; ++tb)
#pragma unroll
                for (int r = 0; r < 4; ++r) { const int t = 16 * tb + 4 * q + r; const f32x4 p0 = *(const LAS f32x4*)(SSQ + t * 8), p1 = *(const LAS f32x4*)(SSQ + t * 8 + 4);
                    const float tot = ((p0[0] + p0[1]) + (p0[2] + p0[3])) + ((p1[0] + p1[1]) + (p1[2] + p1[3])); const float rinv = 1.0f / sqrtf(tot * (1.0f / HD) + EPS);
                    YH[(size_t)(t0 + t) * HW + cb + 16 * w + fr] = (bf16)f2bf(oacc[tb][r] * rinv * hn * bf2f(og[tb * 4 + r])); }
        }
#pragma unroll
        for (int j = 0; j < 8; ++j) { cg[j] = ng[j]; ck[j] = nk[j]; cv[j] = nv[j]; cq[j] = nq[j]; }
    }
    if (!FULL) {
#pragma unroll
        for (int kb = 0; kb < 8; ++kb)
#pragma unroll
            for (int r = 0; r < 4; ++r) Ubuf[(item << 14) + (size_t)(16 * kb + 4 * q + r) * 128 + 16 * w + fr] = S[kb][r];
        if (ro == 0) Dtot[item * 128 + k] = __expf(btot);
    }
    __syncthreads();
}

struct Args { const float* in[15]; float* out; unsigned char* ws; int ph_lo, ph_hi, li, pad; };

__global__ void __launch_bounds__(NWAVES * 64, 2) fwd(Args args) {
    extern __shared__ __attribute__((aligned(16))) unsigned char lds[];
    Frame F;
    F.lds = (LAS unsigned char*)lds;
    F.MISC = (volatile LAS unsigned*)(F.lds + MISC_OFF);
    F.tid = threadIdx.x; F.lane = F.tid & 63; F.wave = __builtin_amdgcn_readfirstlane(F.tid >> 6);
    F.G = gridDim.x; { const int bx = blockIdx.x; F.vcu = (F.G % 8 == 0) ? (bx % 8) * (F.G / 8) + bx / 8 : bx; }
    unsigned char* ws = args.ws;
    F.ctl = (gu32*)(ws + WS_CTL);
    const float* x = args.in[0]; const float* g_mix = args.in[1]; const float* w_in = args.in[2]; const float* w_pg = args.in[3]; const float* pool_scale = args.in[4];
    const float* lb_param = args.in[5]; const float* hgrn_norm = args.in[6]; const float* w_up_pool = args.in[7]; const float* w_up_hgrn = args.in[8]; const float* w_out = args.in[9];
    const float* g_ffn = args.in[10]; const float* w_gate = args.in[11]; const float* w_up = args.in[12]; const float* w_down = args.in[13]; const float* g_final = args.in[14];
    float* out = args.out;
    bf16* WinT = (bf16*)(ws + WS_WIN); bf16* WpgT = (bf16*)(ws + WS_WPG); bf16* WupT = (bf16*)(ws + WS_WUP); bf16* WuhT = (bf16*)(ws + WS_WUH); bf16* WoT = (bf16*)(ws + WS_WO);
    bf16* WguT = (bf16*)(ws + WS_WGU); bf16* WdT = (bf16*)(ws + WS_WD);
    bf16* U = (bf16*)(ws + WS_U); bf16* MG = U;
    bf16* Zb = (bf16*)(ws + WS_Z); bf16* QSb = (bf16*)(ws + WS_QS); bf16* Gb = (bf16*)(ws + WS_G); bf16* KKb = (bf16*)(ws + WS_KK); bf16* Vb = (bf16*)(ws + WS_V); bf16* OGb = (bf16*)(ws + WS_OG);
    bf16* GAb = (bf16*)(ws + WS_GA); bf16* GBb = (bf16*)(ws + WS_GB); bf16* ACT = (bf16*)(ws + WS_ACT);
    bf16* Pb = (bf16*)(ws + WS_P); bf16* YP = (bf16*)(ws + WS_YP); bf16* YH = (bf16*)(ws + WS_YH); bf16* H1B = (bf16*)(ws + WS_H1B);
    float* HU = (float*)(ws + WS_HU); float* HS = (float*)(ws + WS_HS); float* HDt = (float*)(ws + WS_HD); float* SSQ1 = (float*)(ws + WS_SSQ1); float* SSQ2 = (float*)(ws + WS_SSQ2); float* RS1 = (float*)(ws + WS_RS1);

    for (int u = F.tid; u < (LDS_BYTES - LDSCTL_OFF) / 4; u += NWAVES * 64) ((LAS unsigned*)(F.lds + LDSCTL_OFF))[u] = 0u;
    __syncthreads();
    XcdBarrier bar; bar.bar = (unsigned*)(F.ctl + 4096); bar.x = 0; bar.st = nullptr;
    if (N_LAUNCHES == 1) bar = xcd_barrier_post((unsigned*)(F.ctl + 4096), F.MISC + 8);
#define GRID_BAR() do { if (N_LAUNCHES == 1) xcd_barrier(bar); } while (0)
    const int lo = args.ph_lo, hi = args.ph_hi;
#define IN(k) (lo <= (k) && (k) < hi)
#define BOTH(k) (IN(k) && IN((k) + 1))
    const int gw = F.vcu * NWAVES + F.wave, NGW = F.G * NWAVES;
    const int gt = F.vcu * (NWAVES * 64) + F.tid, NGT = F.G * NWAVES * 64;

    if (IN(0)) {
        LAS float* scr = (LAS float*)(F.lds + RING_OFF + F.wave * 16384);
        p0_transpose_matrix(w_in, D, NIN, WinT, D, 0, scr, gw, NGW, F.lane);
#pragma unroll 1
        for (int gi = 0; gi < 4; ++gi) p0_transpose_matrix(w_pg + (size_t)gi * 512 * 512, 512, 512, WpgT + (size_t)gi * 512 * 512, 512, 0, scr, gw, NGW, F.lane);
        p0_transpose_matrix(w_up_pool, PW, D, WupT, PW, 0, scr, gw, NGW, F.lane);
        p0_transpose_matrix(w_up_hgrn, HW, D, WuhT, HW, 0, scr, gw, NGW, F.lane);
        p0_transpose_matrix(w_out, D, D, WoT, D, 0, scr, gw, NGW, F.lane);
        p0_transpose_matrix(w_gate, D, DFF, WguT, D, 1, scr, gw, NGW, F.lane);
        p0_transpose_matrix(w_up, D, DFF, WguT, D, 2, scr, gw, NGW, F.lane);
        p0_transpose_matrix(w_down, DFF, D, WdT, DFF, 0, scr, gw, NGW, F.lane);
        for (int m = gw; m < T; m += NGW) {
            const GAS f32x4* xr = (const GAS f32x4*)(x + (size_t)m * D) + F.lane; const GAS f32x4* gr = (const GAS f32x4*)g_mix + F.lane;
            f32x4 v[16]; float s = 0.f;
#pragma unroll
            for (int j = 0; j < 16; ++j) { v[j] = xr[64 * j]; s += (v[j][0] * v[j][0] + v[j][1] * v[j][1]) + (v[j][2] * v[j][2] + v[j][3] * v[j][3]); }
            const float r = 1.0f / sqrtf(wave_sum(s) * (1.0f / D) + EPS);
            GAS v2u* o8 = (GAS v2u*)(U + (size_t)m * D) + F.lane;
#pragma unroll
            for (int j = 0; j < 16; ++j) { const f32x4 gg = gr[64 * j]; v2u w; w.x = pk2(v[j][0] * r * gg[0], v[j][1] * r * gg[1]); w.y = pk2(v[j][2] * r * gg[2], v[j][3] * r * gg[3]); o8[64 * j] = w; }
        }
        if (BOTH(0)) GRID_BAR();
    }
    if (IN(1)) {
        pg8::Gemm g{U, WinT, T, NIN, D, D, D, 0, 0}; pg8::StaticOrder S; S.init(T, NIN, F.G, (int)blockIdx.x);
        EpiProj E{Zb, lb_param};
        pg8::gemm_phase<EpiProj, pg8::StaticOrder, true, true>(F.lds + RING_OFF, g, S, E);
        if (BOTH(1)) GRID_BAR();
    }
    if (IN(2)) {
        for (int it = gt; it < T * (PW / 8); it += NGT) {
            const int t = it >> 8, c8 = (it & 255) * 8; const int w = 2 << (c8 >> 9); const int cnt = (t + 1 < w) ? t + 1 : w;
            float s[8], z0[8];
#pragma unroll
            for (int j = 0; j < 8; ++j) s[j] = 0.f;
            for (int d = 0; d < cnt; ++d) { const v4u q = *(const GAS v4u*)(Zb + (size_t)(t - d) * PW + c8);
                const float e[8] = {bf_lo(q.x), bf_hi(q.x), bf_lo(q.y), bf_hi(q.y), bf_lo(q.z), bf_hi(q.z), bf_lo(q.w), bf_hi(q.w)};
#pragma unroll
                for (int j = 0; j < 8; ++j) { s[j] += e[j]; if (d == 0) z0[j] = e[j]; } }
            const float inv = 1.0f / (float)cnt; v4u o;
            o.x = pk2(s[0] * inv - z0[0], s[1] * inv - z0[1]); o.y = pk2(s[2] * inv - z0[2], s[3] * inv - z0[3]); o.z = pk2(s[4] * inv - z0[4], s[5] * inv - z0[5]); o.w = pk2(s[6] * inv - z0[6], s[7] * inv - z0[7]);
            *(GAS v4u*)(Pb + (size_t)t * PW + c8) = o;
        }
        for (int b = F.vcu; b < NH * 16; b += F.G)
            hgrn_pass<false>(F.lds + RING_OFF, b >> 4, b & 15, QSb, Gb, KKb, Vb, OGb, hgrn_norm, HU, HDt, HS, YH, F.tid, F.lane, F.wave);
        if (BOTH(2)) GRID_BAR();
    }
    if (IN(3)) {
        pg8::Gemm g{Pb, WpgT, T, PW, 512, PW, 512, 1, 512}; pg8::StaticOrder S; S.init(T, PW, F.G, (int)blockIdx.x);
        EpiScaleBf16 E{YP, PW, pool_scale};
        pg8::gemm_phase<EpiScaleBf16, pg8::StaticOrder, true, true>(F.lds + RING_OFF, g, S, E);
        for (int e = gt; e < NH * HD * HD; e += NGT) {
            const int h = e >> 14, kv = e & 16383, k = kv >> 7; float Sc = 0.f;
#pragma unroll
            for (int sc = 0; sc < 16; ++sc) { const size_t it = (size_t)(h * 16 + sc); HS[(it << 14) + kv] = Sc; Sc = HDt[it * 128 + k] * Sc + HU[(it << 14) + kv]; }
        }
        if (BOTH(3)) GRID_BAR();
    }
    if (IN(4)) {
        for (int b = F.vcu; b < NH * 16; b += F.G)
            hgrn_pass<true>(F.lds + RING_OFF, b >> 4, b & 15, QSb, Gb, KKb, Vb, OGb, hgrn_norm, HU, HDt, HS, YH, F.tid, F.lane, F.wave);
        { pg8::Gemm g{YP, WupT, T, D, PW, PW, PW, 0, 0}; pg8::StaticOrder S; S.init(T, D, F.G, (int)blockIdx.x);
          EpiGateF32 E{out, GAb};
          pg8::gemm_phase<EpiGateF32, pg8::StaticOrder, true, true>(F.lds + RING_OFF, g, S, E); }
        if (BOTH(4)) GRID_BAR();
    }
    if (IN(5)) {
        { pg8::Gemm g{YH, WuhT, T, D, HW, HW, HW, 0, 0}; pg8::StaticOrder S; S.init(T, D, F.G, (int)blockIdx.x);
          EpiGateAddBf16 E{out, GBb, MG};
          pg8::gemm_phase<EpiGateAddBf16, pg8::StaticOrder, true, true>(F.lds + RING_OFF, g, S, E); }
        if (BOTH(5)) GRID_BAR();
    }
    if (IN(6)) {
        pg8::Gemm g{MG, WoT, T, D, D, D, D, 0, 0}; pg8::StaticOrder S; S.init(T, D, F.G, (int)blockIdx.x);
        EpiResid<true> E{x, out, H1B, g_ffn, SSQ1};
        pg8::gemm_phase<EpiResid<true>, pg8::StaticOrder, true, true>(F.lds + RING_OFF, g, S, E);
        if (BOTH(6)) GRID_BAR();
    }
    if (IN(7)) {
        for (int r = gt; r < T; r += NGT) { float s = 0.f;
#pragma unroll 8
            for (int p = 0; p < 64; ++p) s += SSQ1[(size_t)p * T + r];
            RS1[r] = 1.0f / sqrtf(s * (1.0f / D) + EPS); }
        if (BOTH(7)) GRID_BAR();
    }
    if (IN(8)) {
        pg8::Gemm g{H1B, WguT, T, 2 * DFF, D, D, D, 0, 0}; pg8::StaticOrder S; S.init(T, 2 * DFF, F.G, (int)blockIdx.x);
        EpiSwiGLU E{ACT, RS1};
        pg8::gemm_phase<EpiSwiGLU, pg8::StaticOrder, true, true>(F.lds + RING_OFF, g, S, E);
        if (BOTH(8)) GRID_BAR();
    }
    if (IN(9)) {
        pg8::Gemm g{ACT, WdT, T, D, DFF, DFF, DFF, 0, 0}; pg8::StaticOrder S; S.init(T, D, F.G, (int)blockIdx.x);
        EpiResid<false> E{out, out, nullptr, nullptr, SSQ2};
        pg8::gemm_phase<EpiResid<false>, pg8::StaticOrder, true, true>(F.lds + RING_OFF, g, S, E);
        if (BOTH(9)) GRID_BAR();
    }
    if (IN(10)) {
        for (int m = gw; m < T; m += NGW) {
            const float r = 1.0f / sqrtf(wave_sum(SSQ2[(size_t)F.lane * T + m]) * (1.0f / D) + EPS);
            GAS f32x4* orow = (GAS f32x4*)(out + (size_t)m * D) + F.lane; const GAS f32x4* gr = (const GAS f32x4*)g_final + F.lane;
#pragma unroll
            for (int j = 0; j < 16; ++j) { const f32x4 v = orow[64 * j]; const f32x4 gg = gr[64 * j]; orow[64 * j] = v * r * gg; }
        }
    }
#undef IN
#undef BOTH
#undef GRID_BAR
}

extern "C" void kernel_launch(void* const* d_in, const int* in_sizes, int n_in, void* d_out, int out_size, void* d_ws, size_t ws_size, hipStream_t stream) {
    static int grid = 0;
    if (grid == 0) {
        if (n_in != 15 || in_sizes[0] != T * D || out_size != T * D || ws_size < WS_END) { fprintf(stderr, "kernel_launch: unexpected shapes: n_in %d in0 %d out %d ws %zu (need %zu)\n", n_in, n_in > 0 ? in_sizes[0] : -1, out_size, ws_size, (size_t)WS_END); grid = -1; return; }
        int dev = 0, cus = 0, per_cu = 0;
        if (hipGetDevice(&dev) != hipSuccess || hipDeviceGetAttribute(&cus, hipDeviceAttributeMultiprocessorCount, dev) != hipSuccess) { grid = -1; return; }
        if (hipFuncSetAttribute((const void*)fwd, hipFuncAttributeMaxDynamicSharedMemorySize, LDS_BYTES) != hipSuccess) { fprintf(stderr, "kernel_launch: hipFuncSetAttribute failed\n"); grid = -1; return; }
        if (hipOccupancyMaxActiveBlocksPerMultiprocessor(&per_cu, (const void*)fwd, NWAVES * 64, LDS_BYTES) != hipSuccess || per_cu < 1) fprintf(stderr, "kernel_launch: occupancy query says %d\n", per_cu);
        (void)hipGetLastError();
        grid = cus;
    }
    if (grid < 0) return;
    if (hipMemsetAsync((char*)d_ws + WS_CTL, 0, CTL_ZERO_BYTES, stream) != hipSuccess) return;
    Args a{};
    for (int i = 0; i < 15; ++i) a.in[i] = (const float*)d_in[i];
    a.out = (float*)d_out; a.ws = (unsigned char*)d_ws;
    for (int li = 0; li < N_LAUNCHES; ++li) {
        a.ph_lo = (N_LAUNCHES == NPHASE) ? li : 0; a.ph_hi = (N_LAUNCHES == NPHASE) ? li + 1 : NPHASE; a.li = li;
        hipLaunchKernelGGL(fwd, dim3(grid), dim3(NWAVES * 64), LDS_BYTES, stream, a);
        if (N_LAUNCHES == NPHASE && li == PROBE_DUP) hipLaunchKernelGGL(fwd, dim3(grid), dim3(NWAVES * 64), LDS_BYTES, stream, a);
        const hipError_t le = hipPeekAtLastError();
        if (le != hipSuccess) { fprintf(stderr, "kernel_launch: launch %d failed: %s\n", li, hipGetErrorName(le)); break; }
    }
}
```

```cpp
#include <hip/hip_runtime.h>
#include <cstdio>
#include <cstdint>

#ifndef PROBE_DUP
#define PROBE_DUP -1
#endif
#ifndef PROBE_REPS
#define PROBE_REPS 1
#endif
#ifndef MK_N_LAUNCHES
#define MK_N_LAUNCHES 1
#endif

namespace pg8 {
#define PG8_LAS __attribute__((address_space(3)))
typedef unsigned short bf16_t;
typedef short bf16x8 __attribute__((ext_vector_type(8)));
typedef float f32x4 __attribute__((ext_vector_type(4)));
typedef unsigned u32x4 __attribute__((ext_vector_type(4)));
typedef unsigned u32x2 __attribute__((ext_vector_type(2)));
constexpr int BM = 256, BK = 64, HALF = 128, HTB = HALF * BK * 2  , STAGE_BYTES = 8 * HTB, NXCD = 8, WGM = 8;

__host__ __device__ __forceinline__ int lds_byte(int r, int c) { const int st = (r >> 4) * 2 + (c >> 5), rr = r & 15, cc = c & 31, ob = rr * 64 + cc * 2; return st * 1024 + (ob ^ (((ob >> 9) & 1) << 5)); }
__host__ __device__ __forceinline__ void stage_rc(int b, int& R, int& C) { const int st = b / 1024, sb = b % 1024, swz = sb ^ (((sb >> 9) & 1) << 5); R = (st >> 1) * 16 + swz / 64; C = (st & 1) * 32 + (swz % 64) / 2; }
__host__ __device__ __forceinline__ int perm32(int rho) { const int n = rho >> 4, i = rho & 15; return 8 * (i >> 2) + 4 * n + (i & 3); }

struct Unit { int pm, pn; };
struct Gemm { const bf16_t* A; const bf16_t* Bt; int M, N, K, lda, ldb, agrp_shift, agrp_stride; };

struct StaticOrder {
    int nM, nN, nwg, G, c;
    __host__ __device__ void init(int M, int N, int G_, int c_) { nM = M / BM; nN = N / BM; nwg = nM * nN; G = G_; c = c_; }
    __host__ __device__ bool next(int i, Unit& u) const {
        const long L = (long)i * G + c; if (L >= nwg) return false;
        int wgid = (int)L; { const int q = nwg / NXCD, r = nwg % NXCD, xcd = wgid % NXCD, off = wgid / NXCD; wgid = (xcd < r ? xcd * (q + 1) : r * (q + 1) + (xcd - r) * q) + off; }
        const int nig = WGM * nN, gid = wgid / nig, fm = gid * WGM, gsz = (nM - fm) < WGM ? (nM - fm) : WGM;
        u.pm = fm + ((wgid % nig) % gsz); u.pn = (wgid % nig) / gsz; return true;
    }
    __device__ __forceinline__ void a_ready(const Unit&) const {}
    __device__ __forceinline__ void done(const Unit&) const {}
};

__device__ __forceinline__ unsigned cvt_pk_bf16(float lo, float hi) { unsigned r; asm volatile("v_cvt_pk_bf16_f32 %0, %1, %2" : "=v"(r) : "v"(lo), "v"(hi)); return r; }
__device__ __forceinline__ float bf_lo(unsigned w) { return __uint_as_float(w << 16); }
__device__ __forceinline__ float bf_hi(unsigned w) { return __uint_as_float(w & 0xffff0000u); }
__device__ __forceinline__ float fsigmoid(float x) { return __builtin_amdgcn_rcpf(1.0f + __expf(-x)); }
__device__ __forceinline__ float fsilu(float x) { return x * fsigmoid(x); }

template <class Epi, class Sched, bool ALIGN_EPI = false, bool SP2 = false>
__device__ __forceinline__ void gemm_phase(PG8_LAS unsigned char* lds, const Gemm g, const Sched& S, const Epi& E) {
    const int tid = threadIdx.x, wid = __builtin_amdgcn_readfirstlane(tid >> 6), lane = tid & 63, wr = wid >> 2, wc = wid & 3, fr = lane & 15, fq = lane >> 4;
    const int K = g.K, nt = K / BK;
    unsigned voffA[2], voffB[2];
#pragma unroll
    for (int i = 0; i < 2; ++i) { int R, C; stage_rc(tid * 16 + i * 8192, R, C); const int Rb = Epi::PERM ? ((R & ~31) + perm32(R & 31)) : R;
        voffA[i] = (unsigned)(R * g.lda + C) * 2u; voffB[i] = (unsigned)(Rb * g.ldb + C) * 2u; }
    const size_t kstep = (size_t)(BK * 2);
    const size_t hstepA = (size_t)HALF * g.lda * 2, hstepB = (size_t)HALF * g.ldb * 2;
    const size_t tstepA = 2 * hstepA, tstepB = 2 * hstepB;
    const unsigned ldsw = (unsigned)wid * 1024u;
    const int aoff = lds_byte(wr * 64 + fr, fq * 8), boff = lds_byte(wc * 32 + fr, fq * 8);
#define PG8_SA(b, h) (((b) * 2 + (h)) * HTB)
#define PG8_SB(b, h) ((4 + (b) * 2 + (h)) * HTB)
#define PG8_STAGE(bufoff, gbase, voff) do { _Pragma("unroll") for (int _i = 0; _i < 2; ++_i) \
        __builtin_amdgcn_global_load_lds((const unsigned*)((const char*)(gbase) + (voff)[_i]), (PG8_LAS unsigned*)(lds + (bufoff) + ldsw + _i * 8192), 16, 0, 0); } while (0)
#define PG8_LDA(dst, b, h) do { _Pragma("unroll") for (int m = 0; m < 4; ++m) _Pragma("unroll") for (int k = 0; k < 2; ++k) dst[m][k] = *(const PG8_LAS bf16x8*)(lds + PG8_SA(b, h) + aoff + m * 2048 + k * 1024); } while (0)
#define PG8_LDB(dst, b, h) do { _Pragma("unroll") for (int n = 0; n < 2; ++n) _Pragma("unroll") for (int k = 0; k < 2; ++k) dst[n][k] = *(const PG8_LAS bf16x8*)(lds + PG8_SB(b, h) + boff + n * 2048 + k * 1024); } while (0)
#define PG8_MMA(ai, bj, At, Bt) do { __builtin_amdgcn_s_setprio(1); _Pragma("unroll") for (int m = 0; m < 4; ++m) _Pragma("unroll") for (int n = 0; n < 2; ++n) _Pragma("unroll") for (int k = 0; k < 2; ++k) \
        acc[ai][bj][m][n] = __builtin_amdgcn_mfma_f32_16x16x32_bf16(Bt[n][k], At[m][k], acc[ai][bj][m][n], 0, 0, 0); __builtin_amdgcn_s_setprio(0); } while (0)
#define PG8_WAIT_V(n) asm volatile("s_waitcnt vmcnt(" #n ")" ::: "memory")
#define PG8_WAIT_L(n) asm volatile("s_waitcnt lgkmcnt(" #n ")" ::: "memory")
#define PG8_BAR __builtin_amdgcn_s_barrier()
#define PG8_SCHED __builtin_amdgcn_sched_barrier(0)
#define PG8_ABASE(u) ((const char*)g.A + (size_t)(u).pm * tstepA + (g.agrp_stride ? (size_t)(((u).pn >> g.agrp_shift) * g.agrp_stride) * 2 : (size_t)0))
    Unit cur, nxt; int ui = 0;
    if (!S.next(0, cur)) return;
    f32x4 acc[2][2][4][2];
#pragma unroll
    for (int a = 0; a < 2; ++a)
#pragma unroll
        for (int b = 0; b < 2; ++b)
#pragma unroll
            for (int m = 0; m < 4; ++m)
#pragma unroll
                for (int n = 0; n < 2; ++n) acc[a][b][m][n] = (f32x4){0.f, 0.f, 0.f, 0.f};
    bf16x8 At[4][2], B0[2][2], B1[2][2];
    const char* cA = PG8_ABASE(cur); const char* cB = (const char*)g.Bt + (size_t)cur.pn * tstepB;
    S.a_ready(cur);
    if constexpr (SP2) {
        PG8_STAGE(PG8_SB(0, 0), cB, voffB); PG8_STAGE(PG8_SB(0, 1), cB + hstepB, voffB); PG8_STAGE(PG8_SA(0, 0), cA, voffA); PG8_STAGE(PG8_SA(0, 1), cA + hstepA, voffA);
        if (wr == 1) PG8_BAR;
        PG8_WAIT_V(2); PG8_BAR;
        PG8_STAGE(PG8_SB(1, 0), cB + kstep, voffB); PG8_STAGE(PG8_SA(1, 0), cA + kstep, voffA); PG8_STAGE(PG8_SB(1, 1), cB + hstepB + kstep, voffB);
        PG8_WAIT_V(6); PG8_BAR;
    } else {
        PG8_STAGE(PG8_SB(0, 0), cB, voffB); PG8_STAGE(PG8_SA(0, 0), cA, voffA); PG8_STAGE(PG8_SB(0, 1), cB + hstepB, voffB); PG8_STAGE(PG8_SA(0, 1), cA + hstepA, voffA);
        if (wr == 1) PG8_BAR;
        PG8_WAIT_V(4); PG8_BAR;
        PG8_STAGE(PG8_SB(1, 0), cB + kstep, voffB); PG8_STAGE(PG8_SA(1, 0), cA + kstep, voffA); PG8_STAGE(PG8_SB(1, 1), cB + hstepB + kstep, voffB);
        PG8_WAIT_V(6); PG8_BAR;
    }
    for (;;) {
        const bool has_next = S.next(ui + 1, nxt);
        const char* nA = has_next ? PG8_ABASE(nxt) : cA; const char* nB = has_next ? (const char*)g.Bt + (size_t)nxt.pn * tstepB : cB;
        for (int t = 0; t < nt; t += 2) {
            const bool last = (t == nt - 2);
            const char* a1 = cA + (size_t)(t + 1) * kstep;
            const char* a2 = last ? nA : cA + (size_t)(t + 2) * kstep; const char* b2 = last ? nB : cB + (size_t)(t + 2) * kstep;
            const char* a3 = a2 + kstep; const char* b3 = b2 + kstep;
            if (last && has_next) S.a_ready(nxt);
            if constexpr (SP2) {
            PG8_LDB(B0, 0, 0); PG8_LDB(B1, 0, 1); PG8_SCHED; PG8_LDA(At, 0, 0); PG8_STAGE(PG8_SA(1, 1), a1 + hstepA, voffA);
            PG8_WAIT_V(8); PG8_WAIT_L(0); PG8_BAR; PG8_MMA(0, 0, At, B0); PG8_MMA(0, 1, At, B1); PG8_BAR; PG8_SCHED;
            PG8_LDA(At, 0, 1); PG8_STAGE(PG8_SB(0, 0), b2, voffB); PG8_STAGE(PG8_SB(0, 1), b2 + hstepB, voffB); PG8_STAGE(PG8_SA(0, 0), a2, voffA);
            PG8_WAIT_V(8); PG8_WAIT_L(0); PG8_BAR; PG8_MMA(1, 0, At, B0); PG8_MMA(1, 1, At, B1); PG8_BAR; PG8_SCHED;
            PG8_LDB(B0, 1, 0); PG8_LDB(B1, 1, 1); PG8_SCHED; PG8_LDA(At, 1, 0); PG8_STAGE(PG8_SA(0, 1), a2 + hstepA, voffA);
            PG8_WAIT_V(8); PG8_WAIT_L(0); PG8_BAR; PG8_MMA(0, 0, At, B0); PG8_MMA(0, 1, At, B1); PG8_BAR; PG8_SCHED;
            PG8_LDA(At, 1, 1); PG8_STAGE(PG8_SB(1, 0), b3, voffB); PG8_STAGE(PG8_SB(1, 1), b3 + hstepB, voffB); PG8_STAGE(PG8_SA(1, 0), a3, voffA);
            PG8_WAIT_V(8); PG8_WAIT_L(0); PG8_BAR; PG8_MMA(1, 0, At, B0); PG8_MMA(1, 1, At, B1); PG8_BAR; PG8_SCHED;
            } else {
            PG8_LDB(B0, 0, 0); PG8_SCHED; PG8_LDA(At, 0, 0); PG8_STAGE(PG8_SA(1, 1), a1 + hstepA, voffA);
            PG8_WAIT_L(8); PG8_BAR; PG8_WAIT_L(0); PG8_MMA(0, 0, At, B0); PG8_BAR; PG8_SCHED;
            PG8_LDB(B1, 0, 1); PG8_STAGE(PG8_SB(0, 0), b2, voffB);
            PG8_BAR; PG8_WAIT_L(0); PG8_MMA(0, 1, At, B1); PG8_BAR;
            PG8_LDA(At, 0, 1); PG8_STAGE(PG8_SA(0, 0), a2, voffA);
            PG8_BAR; PG8_WAIT_L(0); PG8_MMA(1, 0, At, B0); PG8_BAR; PG8_SCHED;
            PG8_STAGE(PG8_SB(0, 1), b2 + hstepB, voffB);
            PG8_WAIT_V(6); PG8_BAR; PG8_MMA(1, 1, At, B1); PG8_BAR;
            PG8_LDB(B0, 1, 0); PG8_SCHED; PG8_LDA(At, 1, 0); PG8_STAGE(PG8_SA(0, 1), a2 + hstepA, voffA);
            PG8_WAIT_L(8); PG8_BAR; PG8_WAIT_L(0); PG8_MMA(0, 0, At, B0); PG8_BAR; PG8_SCHED;
            PG8_LDB(B1, 1, 1); PG8_STAGE(PG8_SB(1, 0), b3, voffB);
            PG8_BAR; PG8_WAIT_L(0); PG8_MMA(0, 1, At, B1); PG8_BAR;
            PG8_LDA(At, 1, 1); PG8_STAGE(PG8_SA(1, 0), a3, voffA);
            PG8_BAR; PG8_WAIT_L(0); PG8_MMA(1, 0, At, B0); PG8_BAR; PG8_SCHED;
            PG8_STAGE(PG8_SB(1, 1), b3 + hstepB, voffB);
            PG8_WAIT_V(6); PG8_BAR; PG8_MMA(1, 1, At, B1); PG8_BAR;
            }
        }
        if constexpr (ALIGN_EPI) { if (wr == 0) PG8_BAR; }
        E(acc, cur, wr, wc, fr, fq); S.done(cur);
        if (!has_next) break;
#pragma unroll
        for (int a = 0; a < 2; ++a)
#pragma unroll
            for (int b = 0; b < 2; ++b)
#pragma unroll
                for (int m = 0; m < 4; ++m)
#pragma unroll
                    for (int n = 0; n < 2; ++n) acc[a][b][m][n] = (f32x4){0.f, 0.f, 0.f, 0.f};
        cur = nxt; cA = nA; cB = nB; ++ui;
        if constexpr (ALIGN_EPI) { if (wr == 1) PG8_BAR; }
    }
    PG8_WAIT_V(0);
    if constexpr (!ALIGN_EPI) { if (wr == 0) PG8_BAR; }
    PG8_BAR;
#undef PG8_ABASE
#undef PG8_SA
#undef PG8_SB
#undef PG8_STAGE
#undef PG8_LDA
#undef PG8_LDB
#undef PG8_MMA
#undef PG8_WAIT_V
#undef PG8_WAIT_L
#undef PG8_BAR
#undef PG8_SCHED
}
}

constexpr int NWAVES = 8;
constexpr int T = 8192, D = 4096, PW = 2048, HW = 2048, NH = 16, HD = 128, DFF = 11008;
constexpr int NIN = PW + 4 * HW + 2 * D;
constexpr float EPS = 1e-6f;
constexpr int NPHASE = 11;
constexpr int N_LAUNCHES = MK_N_LAUNCHES;

constexpr size_t MiB = 1u << 20;
constexpr size_t WS_CTL = 0, CTL_ZERO_BYTES = 1 * MiB;
constexpr size_t WS_WIN = 1 * MiB;
constexpr size_t WS_WPG = WS_WIN + 144 * MiB;
constexpr size_t WS_WUP = WS_WPG + 2 * MiB;
constexpr size_t WS_WUH = WS_WUP + 16 * MiB;
constexpr size_t WS_WO = WS_WUH + 16 * MiB;
constexpr size_t WS_WGU = WS_WO + 32 * MiB;
constexpr size_t WS_WD = WS_WGU + 172 * MiB;
constexpr size_t WS_U = WS_WD + 86 * MiB;
constexpr size_t WS_PROJ = WS_U + 64 * MiB;
constexpr size_t WS_Z = WS_PROJ, WS_QS = WS_Z + 32 * MiB, WS_G = WS_QS + 32 * MiB, WS_KK = WS_G + 32 * MiB, WS_V = WS_KK + 32 * MiB, WS_OG = WS_V + 32 * MiB;
constexpr size_t WS_GA = WS_OG + 32 * MiB, WS_GB = WS_GA + 64 * MiB;
constexpr size_t WS_ACT = WS_PROJ;
constexpr size_t WS_P = WS_PROJ + 320 * MiB;
constexpr size_t WS_YP = WS_P + 32 * MiB, WS_YH = WS_YP + 32 * MiB;
constexpr size_t WS_H1B = WS_YH + 32 * MiB;
constexpr size_t WS_O = WS_H1B + 64 * MiB;
constexpr size_t WS_HU = WS_O, WS_HS = WS_O + 16 * MiB, WS_HD = WS_O + 32 * MiB;
constexpr size_t WS_SSQ1 = WS_O + 64 * MiB, WS_SSQ2 = WS_SSQ1 + 2 * MiB, WS_RS1 = WS_SSQ2 + 2 * MiB;
constexpr size_t WS_END = WS_RS1 + 1 * MiB;
static_assert(WS_ACT + (size_t)T * DFF * 2 <= WS_P, "ACT overlay fits the projection region");

constexpr int RING_OFF = 0, RING_BYTES = 131072;
constexpr int LDSCTL_OFF = RING_BYTES, MISC_OFF = LDSCTL_OFF + 320;
constexpr int RS_OFF = LDSCTL_OFF + 1024, RS_PANELS = 8;
constexpr int LDS_BYTES = 147456;
static_assert(MISC_OFF + 128 <= RS_OFF && RS_OFF + RS_PANELS * 1024 <= LDS_BYTES, "LDS map");

#define GAS __attribute__((address_space(1)))
#define LAS __attribute__((address_space(3)))
typedef unsigned short bf16;
typedef unsigned v4u __attribute__((ext_vector_type(4)));
typedef unsigned v2u __attribute__((ext_vector_type(2)));
typedef float f32x4 __attribute__((ext_vector_type(4)));
typedef GAS unsigned gu32;
#define RLX_AGENT __ATOMIC_RELAXED, __HIP_MEMORY_SCOPE_AGENT
#define LDS_WAIT() asm volatile("s_waitcnt lgkmcnt(0)" ::: "memory")
#define VM_WAIT() asm volatile("s_waitcnt vmcnt(0)" ::: "memory")
__device__ __forceinline__ unsigned f2bf(float f) { unsigned u = __builtin_bit_cast(unsigned, f); return (u + 0x7fffu + ((u >> 16) & 1u)) >> 16; }
__device__ __forceinline__ unsigned pk2(float lo, float hi) { return f2bf(lo) | (f2bf(hi) << 16); }
__device__ __forceinline__ float bf2f(unsigned short b) { return __uint_as_float(((unsigned)b) << 16); }

#define XB_TMO      128
#define XB_XCNT(j)  (256  + 64 * (j))
#define XB_XSUB(j)  (1280 + 64 * (j))
#define XB_XGEN(j)  (2304 + 64 * (j))
#define XB_TOP      3328
#define XB_TOPGEN   3392
#define XCD_BAR_WORDS 3456
#define XB_SPIN_CAP (1u << 18)
__device__ __forceinline__ unsigned xb_ld(unsigned* p)              { return __hip_atomic_load(p, __ATOMIC_RELAXED, __HIP_MEMORY_SCOPE_AGENT); }
__device__ __forceinline__ unsigned xb_add(unsigned* p, unsigned v) { return __hip_atomic_fetch_add(p, v, __ATOMIC_RELAXED, __HIP_MEMORY_SCOPE_AGENT); }
__device__ __forceinline__ unsigned xb_xcc_id() { return (unsigned)__builtin_amdgcn_s_getreg((3 << 11) | 20) & 0xFu; }
#define XB_SPIN(cond, bar) do { unsigned _sp = 0; while (cond) { __builtin_amdgcn_s_sleep(1); \
    if ((++_sp & 255u) == 0u) { if (xb_ld(&(bar)[XB_TMO])) break; if (_sp > XB_SPIN_CAP) { atomicAdd(&(bar)[XB_TMO], 1u); break; } } } } while (0)
struct XcdBarrier { unsigned* bar; unsigned x; volatile LAS unsigned* st; };
__device__ __forceinline__ XcdBarrier xcd_barrier_post(unsigned* bar, volatile LAS unsigned* st) {
    XcdBarrier b; b.bar = bar; b.x = xb_xcc_id(); b.st = st;
    if (threadIdx.x == 0) (void)xb_add(&bar[XB_XCNT(b.x)], 1u);
    return b;
}
__device__ __forceinline__ void xcd_barrier_complete(unsigned* bar, unsigned x, unsigned& nloc, unsigned& nx) {
    const unsigned G = gridDim.x * gridDim.y * gridDim.z;
    unsigned sum, cnt, mine, sp = 0u;
    for (;;) {
        sum = 0u; cnt = 0u; mine = 0u;
#pragma unroll
        for (unsigned j = 0; j < 16; ++j) { const unsigned c = xb_ld(&bar[XB_XCNT(j)]); sum += c; cnt += (c > 0u) ? 1u : 0u; mine = (j == x) ? c : mine; }
        if (sum == G) break;
        __builtin_amdgcn_s_sleep(1);
        if ((++sp & 255u) == 0u) { if (xb_ld(&bar[XB_TMO])) break; if (sp > XB_SPIN_CAP) { atomicAdd(&bar[XB_TMO], 1u); break; } }
    }
    nloc = mine > 0u ? mine : 1u; nx = cnt > 0u ? cnt : 1u;
}
__device__ __forceinline__ void xcd_barrier(const XcdBarrier& b) {
    asm volatile("s_waitcnt vmcnt(0)" ::: "memory");
    __syncthreads();
    if (threadIdx.x == 0) {
        unsigned* bar = b.bar;
        __builtin_amdgcn_s_waitcnt(0);
        unsigned nloc = b.st[0], nx = b.st[1];
        if (nloc == 0u) { xcd_barrier_complete(bar, b.x, nloc, nx); b.st[0] = nloc; b.st[1] = nx; }
        const unsigned old = xb_add(&bar[XB_XSUB(b.x)], 1u);
        const unsigned gen = old / nloc;
        if (old + 1u == (gen + 1u) * nloc) {
            __builtin_amdgcn_fence(__ATOMIC_RELEASE, "agent");
            asm volatile("s_waitcnt vmcnt(0)" ::: "memory");
            const unsigned og = xb_add(&bar[XB_TOP], 1u);
            const unsigned tg = og / nx;
            if (og + 1u == (tg + 1u) * nx) xb_add(&bar[XB_TOPGEN], 1u);
            else XB_SPIN(xb_ld(&bar[XB_TOPGEN]) == tg, bar);
            __builtin_amdgcn_fence(__ATOMIC_ACQUIRE, "agent");
            xb_add(&bar[XB_XGEN(b.x)], 1u);
            asm volatile("s_waitcnt vmcnt(0)" ::: "memory");
        } else {
            XB_SPIN(xb_ld(&bar[XB_XGEN(b.x)]) == gen, bar);
            __builtin_amdgcn_fence(__ATOMIC_ACQUIRE, "agent");
            asm volatile("s_waitcnt vmcnt(0)" ::: "memory");
        }
    }
    __syncthreads();
}

using pg8::Unit; using pg8::cvt_pk_bf16; using pg8::fsigmoid; using pg8::fsilu; using pg8::bf_lo; using pg8::bf_hi;
constexpr int BM = 256, HALF = 128;

struct EpiProj {
    static constexpr bool PERM = true;
    bf16* PROJ; const float* lbp;
    __device__ __forceinline__ void operator()(const f32x4 (&acc)[2][2][4][2], const Unit& u, int wr, int wc, int fr, int fq) const {
        const int row0 = u.pm * BM + wr * 64 + fr; const int cls = u.pn >> 3;
        int ldc, colt; size_t toff;
        if (cls < 5) { ldc = 2048; colt = (u.pn & 7) * 256; toff = (size_t)(cls + (cls >= 3 ? 1 : 0)) * ((size_t)T * 2048); }
        else { ldc = 4096; colt = (u.pn - (cls < 7 ? 40 : 56)) * 256; toff = (size_t)6 * ((size_t)T * 2048) + (cls < 7 ? (size_t)0 : (size_t)T * 4096); }
        bf16* base = PROJ + toff; bf16* G = PROJ + (size_t)2 * T * 2048; bf16* KK = PROJ + (size_t)3 * T * 2048;
        const int col0 = colt + wc * 32 + 8 * fq;
        if (cls == 2) {
            float lb[2][8];
#pragma unroll
            for (int bj = 0; bj < 2; ++bj) {
                const f32x4 p0a = *(const f32x4*)(lbp + col0 + bj * HALF), p0b = *(const f32x4*)(lbp + col0 + bj * HALF + 4);
                const f32x4 p1a = *(const f32x4*)(lbp + HW + col0 + bj * HALF), p1b = *(const f32x4*)(lbp + HW + col0 + bj * HALF + 4);
#pragma unroll
                for (int j = 0; j < 4; ++j) { lb[bj][j] = __builtin_amdgcn_rcpf(1.0f + __expf(p1a[j] - p0a[j])); lb[bj][4 + j] = __builtin_amdgcn_rcpf(1.0f + __expf(p1b[j] - p0b[j])); }
            }
#pragma unroll
            for (int ai = 0; ai < 2; ++ai)
#pragma unroll
                for (int m = 0; m < 4; ++m) { const size_t ro = (size_t)(row0 + ai * HALF + m * 16) * 2048 + col0;
#pragma unroll
                    for (int bj = 0; bj < 2; ++bj) { float gl[8], kv[8];
#pragma unroll
                        for (int n = 0; n < 2; ++n)
#pragma unroll
                            for (int j = 0; j < 4; ++j) { const float x = fminf(fmaxf(acc[ai][bj][m][n][j], -80.f), 80.f); const float e = __expf(-x); const float sg = __builtin_amdgcn_rcpf(1.0f + e); const float l = lb[bj][4 * n + j];
                                const float f = l + (1.0f - l) * sg; gl[4 * n + j] = __logf(f); kv[4 * n + j] = (1.0f - l) * (e * sg); }
                        pg8::u32x4 w; w.x = cvt_pk_bf16(gl[0], gl[1]); w.y = cvt_pk_bf16(gl[2], gl[3]); w.z = cvt_pk_bf16(gl[4], gl[5]); w.w = cvt_pk_bf16(gl[6], gl[7]);
                        *(pg8::u32x4*)(G + ro + bj * HALF) = w;
                        w.x = cvt_pk_bf16(kv[0], kv[1]); w.y = cvt_pk_bf16(kv[2], kv[3]); w.z = cvt_pk_bf16(kv[4], kv[5]); w.w = cvt_pk_bf16(kv[6], kv[7]);
                        *(pg8::u32x4*)(KK + ro + bj * HALF) = w; } }
            return;
        }
        const int act = (cls == 0 || cls == 3) ? 0 : (cls == 1 || cls == 4) ? 1 : 2;
#pragma unroll
        for (int ai = 0; ai < 2; ++ai)
#pragma unroll
            for (int m = 0; m < 4; ++m) { bf16* rowp = base + (size_t)(row0 + ai * HALF + m * 16) * ldc + col0;
#pragma unroll
                for (int bj = 0; bj < 2; ++bj) { f32x4 v0 = acc[ai][bj][m][0], v1 = acc[ai][bj][m][1];
                    if (act != 0) {
#pragma unroll
                        for (int j = 0; j < 4; ++j) { const float s0 = fsigmoid(v0[j]), s1 = fsigmoid(v1[j]); v0[j] = act == 1 ? v0[j] * s0 : s0; v1[j] = act == 1 ? v1[j] * s1 : s1; } }
                    pg8::u32x4 w; w.x = cvt_pk_bf16(v0[0], v0[1]); w.y = cvt_pk_bf16(v0[2], v0[3]); w.z = cvt_pk_bf16(v1[0], v1[1]); w.w = cvt_pk_bf16(v1[2], v1[3]);
                    *(pg8::u32x4*)(rowp + bj * HALF) = w; } }
    }
};
struct EpiScaleBf16 {
    static constexpr bool PERM = true;
    bf16* O; int ldc; const float* scale;
    __device__ __forceinline__ void operator()(const f32x4 (&acc)[2][2][4][2], const Unit& u, int wr, int wc, int fr, int fq) const {
        const int row0 = u.pm * BM + wr * 64 + fr, col0 = u.pn * BM + wc * 32 + 8 * fq;
        f32x4 sv[2][2];
#pragma unroll
        for (int bj = 0; bj < 2; ++bj)
#pragma unroll
            for (int n = 0; n < 2; ++n) sv[bj][n] = *(const f32x4*)(scale + col0 + bj * HALF + 4 * n);
#pragma unroll
        for (int ai = 0; ai < 2; ++ai)
#pragma unroll
            for (int m = 0; m < 4; ++m) { bf16* rowp = O + (size_t)(row0 + ai * HALF + m * 16) * ldc + col0;
#pragma unroll
                for (int bj = 0; bj < 2; ++bj) { const f32x4 v0 = acc[ai][bj][m][0] * sv[bj][0], v1 = acc[ai][bj][m][1] * sv[bj][1];
                    pg8::u32x4 w; w.x = cvt_pk_bf16(v0[0], v0[1]); w.y = cvt_pk_bf16(v0[2], v0[3]); w.z = cvt_pk_bf16(v1[0], v1[1]); w.w = cvt_pk_bf16(v1[2], v1[3]);
                    *(pg8::u32x4*)(rowp + bj * HALF) = w; } }
    }
};
struct EpiGateF32 {
    static constexpr bool PERM = true;
    float* X; const bf16* GT;
    __device__ __forceinline__ void operator()(const f32x4 (&acc)[2][2][4][2], const Unit& u, int wr, int wc, int fr, int fq) const {
        const int row0 = u.pm * BM + wr * 64 + fr, col0 = u.pn * BM + wc * 32 + 8 * fq;
#pragma unroll
        for (int ai = 0; ai < 2; ++ai)
#pragma unroll
            for (int m = 0; m < 4; ++m) { const size_t ro = (size_t)(row0 + ai * HALF + m * 16) * D + col0;
#pragma unroll
                for (int bj = 0; bj < 2; ++bj) { const pg8::u32x4 gw = *(const pg8::u32x4*)(GT + ro + bj * HALF);
                    f32x4 v0 = acc[ai][bj][m][0], v1 = acc[ai][bj][m][1];
                    v0[0] *= bf_lo(gw.x); v0[1] *= bf_hi(gw.x); v0[2] *= bf_lo(gw.y); v0[3] *= bf_hi(gw.y);
                    v1[0] *= bf_lo(gw.z); v1[1] *= bf_hi(gw.z); v1[2] *= bf_lo(gw.w); v1[3] *= bf_hi(gw.w);
                    *(f32x4*)(X + ro + bj * HALF) = v0; *(f32x4*)(X + ro + bj * HALF + 4) = v1; } }
    }
};
struct EpiGateAddBf16 {
    static constexpr bool PERM = true;
    const float* X; const bf16* GT; bf16* O;
    __device__ __forceinline__ void operator()(const f32x4 (&acc)[2][2][4][2], const Unit& u, int wr, int wc, int fr, int fq) const {
        const int row0 = u.pm * BM + wr * 64 + fr, col0 = u.pn * BM + wc * 32 + 8 * fq;
#pragma unroll
        for (int ai = 0; ai < 2; ++ai)
#pragma unroll
            for (int m = 0; m < 4; ++m) { const size_t ro = (size_t)(row0 + ai * HALF + m * 16) * D + col0;
#pragma unroll
                for (int bj = 0; bj < 2; ++bj) { const pg8::u32x4 gw = *(const pg8::u32x4*)(GT + ro + bj * HALF);
                    const f32x4 x0 = *(const f32x4*)(X + ro + bj * HALF), x1 = *(const f32x4*)(X + ro + bj * HALF + 4);
                    f32x4 v0 = acc[ai][bj][m][0], v1 = acc[ai][bj][m][1];
                    v0[0] = x0[0] + v0[0] * bf_lo(gw.x); v0[1] = x0[1] + v0[1] * bf_hi(gw.x); v0[2] = x0[2] + v0[2] * bf_lo(gw.y); v0[3] = x0[3] + v0[3] * bf_hi(gw.y);
                    v1[0] = x1[0] + v1[0] * bf_lo(gw.z); v1[1] = x1[1] + v1[1] * bf_hi(gw.z); v1[2] = x1[2] + v1[2] * bf_lo(gw.w); v1[3] = x1[3] + v1[3] * bf_hi(gw.w);
                    pg8::u32x4 w; w.x = cvt_pk_bf16(v0[0], v0[1]); w.y = cvt_pk_bf16(v0[2], v0[3]); w.z = cvt_pk_bf16(v1[0], v1[1]); w.w = cvt_pk_bf16(v1[2], v1[3]);
                    *(pg8::u32x4*)(O + ro + bj * HALF) = w; } }
    }
};
template <bool WITH_HB> struct EpiResid {
    static constexpr bool PERM = true;
    const float* R; float* H; bf16* HB; const float* gain; float* SSQ;
    __device__ __forceinline__ void operator()(const f32x4 (&acc)[2][2][4][2], const Unit& u, int wr, int wc, int fr, int fq) const {
        const int row0 = u.pm * BM + wr * 64 + fr, col0 = u.pn * BM + wc * 32 + 8 * fq;
        f32x4 gv[2][2];
        if (WITH_HB) {
#pragma unroll
            for (int bj = 0; bj < 2; ++bj)
#pragma unroll
                for (int n = 0; n < 2; ++n) gv[bj][n] = *(const f32x4*)(gain + col0 + bj * HALF + 4 * n);
        }
#pragma unroll
        for (int ai = 0; ai < 2; ++ai)
#pragma unroll
            for (int m = 0; m < 4; ++m) { const int row = row0 + ai * HALF + m * 16; const size_t ro = (size_t)row * D + col0; float ss = 0.f;
#pragma unroll
                for (int bj = 0; bj < 2; ++bj) {
                    const f32x4 h0 = *(const f32x4*)(R + ro + bj * HALF) + acc[ai][bj][m][0], h1 = *(const f32x4*)(R + ro + bj * HALF + 4) + acc[ai][bj][m][1];
                    ss += (h0[0] * h0[0] + h0[1] * h0[1]) + (h0[2] * h0[2] + h0[3] * h0[3]) + (h1[0] * h1[0] + h1[1] * h1[1]) + (h1[2] * h1[2] + h1[3] * h1[3]);
                    *(f32x4*)(H + ro + bj * HALF) = h0; *(f32x4*)(H + ro + bj * HALF + 4) = h1;
                    if (WITH_HB) { const f32x4 a0 = h0 * gv[bj][0], a1 = h1 * gv[bj][1];
                        pg8::u32x4 w; w.x = cvt_pk_bf16(a0[0], a0[1]); w.y = cvt_pk_bf16(a0[2], a0[3]); w.z = cvt_pk_bf16(a1[0], a1[1]); w.w = cvt_pk_bf16(a1[2], a1[3]);
                        *(pg8::u32x4*)(HB + ro + bj * HALF) = w; }
                }
                ss += __shfl_xor(ss, 16); ss += __shfl_xor(ss, 32);
                if (fq == 0) SSQ[(size_t)(u.pn * 4 + wc) * T + row] = ss;
            }
    }
};
struct EpiNull {
    static constexpr bool PERM = true;
    __device__ __forceinline__ void operator()(const f32x4 (&acc)[2][2][4][2], const Unit&, int, int, int, int) const {
#pragma unroll
        for (int ai = 0; ai < 2; ++ai)
#pragma unroll
            for (int bj = 0; bj < 2; ++bj)
#pragma unroll
                for (int m = 0; m < 4; ++m)
#pragma unroll
                    for (int n = 0; n < 2; ++n) asm volatile("" :: "v"(acc[ai][bj][m][n]));
    }
};
struct EpiSwiGLU {
    static constexpr bool PERM = true;
    bf16* O; const LAS float* RS; int pm_lo;
    __device__ __forceinline__ void operator()(const f32x4 (&acc)[2][2][4][2], const Unit& u, int wr, int wc, int fr, int fq) const {
        const int row0 = u.pm * BM + wr * 64 + fr, col0 = u.pn * HALF + wc * 32 + 8 * fq;
#pragma unroll
        for (int ai = 0; ai < 2; ++ai)
#pragma unroll
            for (int m = 0; m < 4; ++m) { const int row = row0 + ai * HALF + m * 16; const float r = RS[row - pm_lo * BM];
                float o[8];
#pragma unroll
                for (int n = 0; n < 2; ++n)
#pragma unroll
                    for (int j = 0; j < 4; ++j) { const float gt = acc[ai][0][m][n][j] * r, up = acc[ai][1][m][n][j] * r; o[4 * n + j] = fsilu(gt) * up; }
                pg8::u32x4 w; w.x = cvt_pk_bf16(o[0], o[1]); w.y = cvt_pk_bf16(o[2], o[3]); w.z = cvt_pk_bf16(o[4], o[5]); w.w = cvt_pk_bf16(o[6], o[7]);
                *(pg8::u32x4*)(O + (size_t)row * DFF + col0) = w; }
    }
};

struct Frame {
    LAS unsigned char* lds;
    volatile LAS unsigned* MISC;
    gu32* ctl;
    int tid, lane, wave;
    int vcu, G;
};
__device__ __forceinline__ float wave_sum(float v) {
#pragma unroll
    for (int o = 1; o < 64; o <<= 1) v += __shfl_xor(v, o);
    return v;
}
__device__ __forceinline__ void p0_transpose_item(const float* W, int N, bf16* WT, int ldt, int rowmode, LAS float* scr, int kb, int nb, int lane) {
    const int k0 = 64 * kb, n0 = 32 * nb;
    const int lk = lane >> 3, ln = (lane & 7) * 4;
#pragma unroll
    for (int i = 0; i < 8; ++i) { const int kk = 8 * i + lk; const f32x4 v = *(const GAS f32x4*)(W + (size_t)(k0 + kk) * N + n0 + ln);
        scr[kk * 33 + ln] = v[0]; scr[kk * 33 + ln + 1] = v[1]; scr[kk * 33 + ln + 2] = v[2]; scr[kk * 33 + ln + 3] = v[3]; }
    LDS_WAIT(); asm volatile("" ::: "memory");
    const int c = lane & 7;
#pragma unroll
    for (int j = 0; j < 4; ++j) { const int n = (lane >> 3) + 8 * j; const LAS float* s = scr + (8 * c) * 33 + n;
        v4u o; o.x = pk2(s[0 * 33], s[1 * 33]); o.y = pk2(s[2 * 33], s[3 * 33]); o.z = pk2(s[4 * 33], s[5 * 33]); o.w = pk2(s[6 * 33], s[7 * 33]);
        const int ng = n0 + n; const int row = rowmode == 0 ? ng : ((ng >> 7) * 256 + (rowmode == 2 ? 128 : 0) + (ng & 127));
        *(GAS v4u*)(WT + (size_t)row * ldt + k0 + 8 * c) = o; }
    LDS_WAIT(); asm volatile("" ::: "memory");
}
__device__ __forceinline__ void p0_transpose_matrix(const float* W, int K, int N, bf16* WT, int ldt, int rowmode, LAS float* scr, int gw, int NGW, int lane) {
    const int nblk = N / 32, nitems = (K / 64) * nblk;
    for (int it = gw; it < nitems; it += NGW) p0_transpose_item(W, N, WT, ldt, rowmode, scr, it / nblk, it % nblk, lane);
}

template <int W>
__device__ __forceinline__ void pool_item(const bf16* Z, bf16* P, int t4, int c8) {
    v4u rows[W + 3];
#pragma unroll
    for (int i = 0; i < W + 3; ++i) { const int t = t4 - (W - 1) + i; rows[i] = (t >= 0) ? *(const GAS v4u*)(Z + (size_t)t * PW + c8) : (v4u){0u, 0u, 0u, 0u}; }
    float s[8];
#pragma unroll
    for (int j = 0; j < 8; ++j) s[j] = 0.f;
#pragma unroll
    for (int i = 0; i < W - 1; ++i) { const v4u q = rows[i];
        s[0] += pg8::bf_lo(q.x); s[1] += pg8::bf_hi(q.x); s[2] += pg8::bf_lo(q.y); s[3] += pg8::bf_hi(q.y); s[4] += pg8::bf_lo(q.z); s[5] += pg8::bf_hi(q.z); s[6] += pg8::bf_lo(q.w); s[7] += pg8::bf_hi(q.w); }
#pragma unroll
    for (int r = 0; r < 4; ++r) {
        const v4u q = rows[W - 1 + r]; const float z[8] = {pg8::bf_lo(q.x), pg8::bf_hi(q.x), pg8::bf_lo(q.y), pg8::bf_hi(q.y), pg8::bf_lo(q.z), pg8::bf_hi(q.z), pg8::bf_lo(q.w), pg8::bf_hi(q.w)};
#pragma unroll
        for (int j = 0; j < 8; ++j) s[j] += z[j];
        const int t = t4 + r; const float inv = 1.0f / (float)(t + 1 < W ? t + 1 : W);
        v4u o; o.x = pk2(s[0] * inv - z[0], s[1] * inv - z[1]); o.y = pk2(s[2] * inv - z[2], s[3] * inv - z[3]); o.z = pk2(s[4] * inv - z[4], s[5] * inv - z[5]); o.w = pk2(s[6] * inv - z[6], s[7] * inv - z[7]);
        *(GAS v4u*)(P + (size_t)t * PW + c8) = o;
        const v4u d = rows[r];
        s[0] -= pg8::bf_lo(d.x); s[1] -= pg8::bf_hi(d.x); s[2] -= pg8::bf_lo(d.y); s[3] -= pg8::bf_hi(d.y); s[4] -= pg8::bf_lo(d.z); s[5] -= pg8::bf_hi(d.z); s[6] -= pg8::bf_lo(d.w); s[7] -= pg8::bf_hi(d.w);
    }
}

constexpr int HG_QA = 0, HG_KA = HG_QA + 8704, HG_KDT = HG_KA + 8704, HG_VT = HG_KDT + 10240, HG_ST = HG_VT + 10240, HG_P = HG_ST + 34816, HG_OCT = HG_P + 2560, HG_DEC = HG_OCT + 2048, HG_SSQ = HG_DEC + 512, HG_END = HG_SSQ + 1024;
static_assert(HG_END <= RING_BYTES, "HGRN LDS map");
typedef short bf16x8_t __attribute__((ext_vector_type(8)));
template <bool FULL>
__device__ __forceinline__ void hgrn_pass(LAS unsigned char* lds, int h, int sc, const bf16* QS, const bf16* Gl, const bf16* KK, const bf16* Vv, const bf16* OG, const float* hnorm,
                                          float* Ubuf, float* Dtot, const float* Sin, bf16* YH, int tid, int lane, int w) {
    const int k = tid & 127, ro = tid >> 7, fr = lane & 15, q = lane >> 4;
    LAS bf16* QA = (LAS bf16*)(lds + HG_QA); LAS bf16* KA = (LAS bf16*)(lds + HG_KA); LAS bf16* KDT = (LAS bf16*)(lds + HG_KDT); LAS bf16* VT = (LAS bf16*)(lds + HG_VT);
    LAS bf16* ST = (LAS bf16*)(lds + HG_ST); LAS bf16* Pm = (LAS bf16*)(lds + HG_P); LAS float* OCT = (LAS float*)(lds + HG_OCT); LAS float* DEC = (LAS float*)(lds + HG_DEC); LAS float* SSQ = (LAS float*)(lds + HG_SSQ);
    const size_t item = (size_t)(h * 16 + sc);
    f32x4 S[8];
#pragma unroll
    for (int kb = 0; kb < 8; ++kb) {
        if (FULL) {
#pragma unroll
            for (int r = 0; r < 4; ++r) S[kb][r] = Sin[(item << 14) + (size_t)(16 * kb + 4 * q + r) * 128 + 16 * w + fr];
        } else S[kb] = (f32x4){0.f, 0.f, 0.f, 0.f};
    }
    if (FULL) { for (int i = tid; i < 32 * 40; i += 512) Pm[i] = 0; }
    const size_t cb = (size_t)h * HD;
    const int t00 = sc * 512;
    const float hn = FULL ? hnorm[h * HD + 16 * w + fr] : 0.f;
    float btot = 0.f;
    unsigned short cg[8], ck[8], cv[8], cq[8], ng[8], nk[8], nv[8], nq[8], og[8];
#pragma unroll
    for (int j = 0; j < 8; ++j) { const size_t ro_ = (size_t)(t00 + 8 * ro + j) * HW + cb + k; cg[j] = Gl[ro_]; ck[j] = KK[ro_]; cv[j] = Vv[ro_]; cq[j] = FULL ? QS[ro_] : (unsigned short)0; }
#pragma unroll
    for (int j = 0; j < 8; ++j) { const size_t ro_ = (size_t)(t00 + 32 + 8 * ro + j) * HW + cb + k; ng[j] = Gl[ro_]; nk[j] = KK[ro_]; nv[j] = Vv[ro_]; nq[j] = FULL ? QS[ro_] : (unsigned short)0; }
    if (FULL) {
#pragma unroll
        for (int tb = 0; tb < 2; ++tb)
#pragma unroll
            for (int r = 0; r < 4; ++r) og[tb * 4 + r] = OG[(size_t)(t00 + 16 * tb + 4 * q + r) * HW + cb + 16 * w + fr];
    }
#pragma unroll 1
    for (int blk = 0; blk < 16; ++blk) {
        const int t0 = t00 + 32 * blk;
        unsigned short mg[8], mk[8], mv[8], mq[8], nog[8];
        { const int tp = (blk < 14 ? t0 + 64 : t0);
#pragma unroll
          for (int j = 0; j < 8; ++j) { const size_t ro_ = (size_t)(tp + 8 * ro + j) * HW + cb + k; mg[j] = Gl[ro_]; mk[j] = KK[ro_]; mv[j] = Vv[ro_]; mq[j] = FULL ? QS[ro_] : (unsigned short)0; } }
        if (FULL) { const int tp = (blk < 15 ? t0 + 32 : t0);
#pragma unroll
            for (int tb = 0; tb < 2; ++tb)
#pragma unroll
                for (int r = 0; r < 4; ++r) nog[tb * 4 + r] = OG[(size_t)(tp + 16 * tb + 4 * q + r) * HW + cb + 16 * w + fr];
        }
        float c[8]; c[0] = bf2f(cg[0]);
#pragma unroll
        for (int j = 1; j < 8; ++j) c[j] = c[j - 1] + bf2f(cg[j]);
        OCT[ro * 128 + k] = c[7];
        __syncthreads();
        const float o0 = OCT[k], o1 = OCT[128 + k], o2 = OCT[256 + k], o3 = OCT[384 + k];
        const float off = (ro > 0 ? o0 : 0.f) + (ro > 1 ? o1 : 0.f) + (ro > 2 ? o2 : 0.f); const float b32 = (o0 + o1) + (o2 + o3);
        btot += b32;
        { unsigned kdw[4], vw[4];
#pragma unroll
          for (int j = 0; j < 8; j += 2) {
              const float b0 = off + c[j], b1 = off + c[j + 1]; const float k0 = bf2f(ck[j]), k1 = bf2f(ck[j + 1]);
              kdw[j >> 1] = pk2(k0 * __expf(b32 - b0), k1 * __expf(b32 - b1)); vw[j >> 1] = (unsigned)cv[j] | ((unsigned)cv[j + 1] << 16);
              if (FULL) { const float e0 = __expf(b0), e1 = __expf(b1); const float i0 = __expf(fminf(-b0, 80.f)), i1 = __expf(fminf(-b1, 80.f));
                  QA[(8 * ro + j) * 136 + k] = (bf16)f2bf(bf2f(cq[j]) * e0); QA[(8 * ro + j + 1) * 136 + k] = (bf16)f2bf(bf2f(cq[j + 1]) * e1);
                  KA[(8 * ro + j) * 136 + k] = (bf16)f2bf(k0 * i0); KA[(8 * ro + j + 1) * 136 + k] = (bf16)f2bf(k1 * i1); }
          }
          *(LAS v4u*)(KDT + k * 40 + 8 * ro) = (v4u){kdw[0], kdw[1], kdw[2], kdw[3]};
          *(LAS v4u*)(VT + k * 40 + 8 * ro) = (v4u){vw[0], vw[1], vw[2], vw[3]}; }
        if (ro == 0) DEC[k] = __expf(b32);
        if (FULL) {
#pragma unroll
            for (int kb = 0; kb < 8; ++kb) { v2u wv; wv.x = pk2(S[kb][0], S[kb][1]); wv.y = pk2(S[kb][2], S[kb][3]); *(LAS v2u*)(ST + (16 * w + fr) * 136 + 16 * kb + 4 * q) = wv; }
        }
        __syncthreads();
        f32x4 oacc[2] = {(f32x4){0.f, 0.f, 0.f, 0.f}, (f32x4){0.f, 0.f, 0.f, 0.f}};
        const bf16x8_t bV = *(const LAS bf16x8_t*)(VT + (16 * w + fr) * 40 + 8 * q);
        if (FULL) {
            if (w < 3) {
                const int tb = w > 0 ? 1 : 0, sb = w > 1 ? 1 : 0; f32x4 pa = (f32x4){0.f, 0.f, 0.f, 0.f};
#pragma unroll
                for (int kk = 0; kk < 4; ++kk) { const bf16x8_t a = *(const LAS bf16x8_t*)(QA + (16 * tb + fr) * 136 + 32 * kk + 8 * q); const bf16x8_t b = *(const LAS bf16x8_t*)(KA + (16 * sb + fr) * 136 + 32 * kk + 8 * q);
                    pa = __builtin_amdgcn_mfma_f32_16x16x32_bf16(a, b, pa, 0, 0, 0); }
#pragma unroll
                for (int r = 0; r < 4; ++r) { const int t = 16 * tb + 4 * q + r, s_ = 16 * sb + fr; Pm[t * 40 + s_] = (bf16)f2bf(s_ <= t ? pa[r] : 0.f); }
            }
#pragma unroll
            for (int tb = 0; tb < 2; ++tb)
#pragma unroll
                for (int kk = 0; kk < 4; ++kk) { const bf16x8_t a = *(const LAS bf16x8_t*)(QA + (16 * tb + fr) * 136 + 32 * kk + 8 * q); const bf16x8_t b = *(const LAS bf16x8_t*)(ST + (16 * w + fr) * 136 + 32 * kk + 8 * q);
                    oacc[tb] = __builtin_amdgcn_mfma_f32_16x16x32_bf16(a, b, oacc[tb], 0, 0, 0); }
        }
#pragma unroll
        for (int kb = 0; kb < 8; ++kb) { const f32x4 d4 = *(const LAS f32x4*)(DEC + 16 * kb + 4 * q); const bf16x8_t a = *(const LAS bf16x8_t*)(KDT + (16 * kb + fr) * 40 + 8 * q);
            S[kb] = __builtin_amdgcn_mfma_f32_16x16x32_bf16(a, bV, S[kb] * d4, 0, 0, 0); }
        if (FULL) {
            __syncthreads();
#pragma unroll
            for (int tb = 0; tb < 2; ++tb) { const bf16x8_t a = *(const LAS bf16x8_t*)(Pm + (16 * tb + fr) * 40 + 8 * q); oacc[tb] = __builtin_amdgcn_mfma_f32_16x16x32_bf16(a, bV, oacc[tb], 0, 0, 0); }
#pragma unroll
            for (int tb = 0; tb < 2; ++tb)
#pragma unroll
                for (int r = 0; r < 4; ++r) { float ss = oacc[tb][r] * oacc[tb][r]; ss += __shfl_xor(ss, 1); ss += __shfl_xor(ss, 2); ss += __shfl_xor(ss, 4); ss += __shfl_xor(ss, 8);
                    if (fr == 0) SSQ[(16 * tb + 4 * q + r) * 8 + w] = ss; }
            __syncthreads();
#pragma unroll
            for (int tb = 0; tb < 2; ++tb)
#pragma unroll
                for (int r = 0; r < 4; ++r) { const int t = 16 * tb + 4 * q + r; const f32x4 p0 = *(const LAS f32x4*)(SSQ + t * 8), p1 = *(const LAS f32x4*)(SSQ + t * 8 + 4);
                    const float tot = ((p0[0] + p0[1]) + (p0[2] + p0[3])) + ((p1[0] + p1[1]) + (p1[2] + p1[3])); const float rinv = 1.0f / sqrtf(tot * (1.0f / HD) + EPS);
                    YH[(size_t)(t0 + t) * HW + cb + 16 * w + fr] = (bf16)f2bf(oacc[tb][r] * rinv * hn * bf2f(og[tb * 4 + r])); }
        }
#pragma unroll
        for (int j = 0; j < 8; ++j) { cg[j] = ng[j]; ck[j] = nk[j]; cv[j] = nv[j]; cq[j] = nq[j]; ng[j] = mg[j]; nk[j] = mk[j]; nv[j] = mv[j]; nq[j] = mq[j]; if (FULL) og[j] = nog[j]; }
    }
    if (!FULL) {
#pragma unroll
        for (int kb = 0; kb < 8; ++kb)
#pragma unroll
            for (int r = 0; r < 4; ++r) Ubuf[(item << 14) + (size_t)(16 * kb + 4 * q + r) * 128 + 16 * w + fr] = S[kb][r];
        if (ro == 0) Dtot[item * 128 + k] = __expf(btot);
    }
    __syncthreads();
}

struct Args { const float* in[15]; float* out; unsigned char* ws; int ph_lo, ph_hi, li, pad; };

__global__ void __launch_bounds__(NWAVES * 64, 2) fwd(Args args) {
    extern __shared__ __attribute__((aligned(16))) unsigned char lds[];
    Frame F;
    F.lds = (LAS unsigned char*)lds;
    F.MISC = (volatile LAS unsigned*)(F.lds + MISC_OFF);
    F.tid = threadIdx.x; F.lane = F.tid & 63; F.wave = __builtin_amdgcn_readfirstlane(F.tid >> 6);
    F.G = gridDim.x; { const int bx = blockIdx.x; F.vcu = (F.G % 8 == 0) ? (bx % 8) * (F.G / 8) + bx / 8 : bx; }
    unsigned char* ws = args.ws;
    F.ctl = (gu32*)(ws + WS_CTL);
    const float* x = args.in[0]; const float* g_mix = args.in[1]; const float* w_in = args.in[2]; const float* w_pg = args.in[3]; const float* pool_scale = args.in[4];
    const float* lb_param = args.in[5]; const float* hgrn_norm = args.in[6]; const float* w_up_pool = args.in[7]; const float* w_up_hgrn = args.in[8]; const float* w_out = args.in[9];
    const float* g_ffn = args.in[10]; const float* w_gate = args.in[11]; const float* w_up = args.in[12]; const float* w_down = args.in[13]; const float* g_final = args.in[14];
    float* out = args.out;
    bf16* WinT = (bf16*)(ws + WS_WIN); bf16* WpgT = (bf16*)(ws + WS_WPG); bf16* WupT = (bf16*)(ws + WS_WUP); bf16* WuhT = (bf16*)(ws + WS_WUH); bf16* WoT = (bf16*)(ws + WS_WO);
    bf16* WguT = (bf16*)(ws + WS_WGU); bf16* WdT = (bf16*)(ws + WS_WD);
    bf16* U = (bf16*)(ws + WS_U); bf16* MG = U;
    bf16* Zb = (bf16*)(ws + WS_Z); bf16* QSb = (bf16*)(ws + WS_QS); bf16* Gb = (bf16*)(ws + WS_G); bf16* KKb = (bf16*)(ws + WS_KK); bf16* Vb = (bf16*)(ws + WS_V); bf16* OGb = (bf16*)(ws + WS_OG);
    bf16* GAb = (bf16*)(ws + WS_GA); bf16* GBb = (bf16*)(ws + WS_GB); bf16* ACT = (bf16*)(ws + WS_ACT);
    bf16* Pb = (bf16*)(ws + WS_P); bf16* YP = (bf16*)(ws + WS_YP); bf16* YH = (bf16*)(ws + WS_YH); bf16* H1B = (bf16*)(ws + WS_H1B);
    float* HU = (float*)(ws + WS_HU); float* HS = (float*)(ws + WS_HS); float* HDt = (float*)(ws + WS_HD); float* SSQ1 = (float*)(ws + WS_SSQ1); float* SSQ2 = (float*)(ws + WS_SSQ2); float* RS1 = (float*)(ws + WS_RS1);

    for (int u = F.tid; u < (LDS_BYTES - LDSCTL_OFF) / 4; u += NWAVES * 64) ((LAS unsigned*)(F.lds + LDSCTL_OFF))[u] = 0u;
    __syncthreads();
    XcdBarrier bar; bar.bar = (unsigned*)(F.ctl + 4096); bar.x = 0; bar.st = nullptr;
    if (N_LAUNCHES == 1) bar = xcd_barrier_post((unsigned*)(F.ctl + 4096), F.MISC + 8);
#define GRID_BAR() do { if (N_LAUNCHES == 1) xcd_barrier(bar); } while (0)
    const int lo = args.ph_lo, hi = args.ph_hi;
#define IN(k) (lo <= (k) && (k) < hi)
#define BOTH(k) (IN(k) && IN((k) + 1))
    const int gw = F.vcu * NWAVES + F.wave, NGW = F.G * NWAVES;
    const int gt = F.vcu * (NWAVES * 64) + F.tid, NGT = F.G * NWAVES * 64;

    if (IN(0)) {
        LAS float* scr = (LAS float*)(F.lds + RING_OFF + F.wave * 16384);
        p0_transpose_matrix(w_in, D, NIN, WinT, D, 0, scr, gw, NGW, F.lane);
#pragma unroll 1
        for (int gi = 0; gi < 4; ++gi) p0_transpose_matrix(w_pg + (size_t)gi * 512 * 512, 512, 512, WpgT + (size_t)gi * 512 * 512, 512, 0, scr, gw, NGW, F.lane);
        p0_transpose_matrix(w_up_pool, PW, D, WupT, PW, 0, scr, gw, NGW, F.lane);
        p0_transpose_matrix(w_up_hgrn, HW, D, WuhT, HW, 0, scr, gw, NGW, F.lane);
        p0_transpose_matrix(w_out, D, D, WoT, D, 0, scr, gw, NGW, F.lane);
        p0_transpose_matrix(w_gate, D, DFF, WguT, D, 1, scr, gw, NGW, F.lane);
        p0_transpose_matrix(w_up, D, DFF, WguT, D, 2, scr, gw, NGW, F.lane);
        p0_transpose_matrix(w_down, DFF, D, WdT, DFF, 0, scr, gw, NGW, F.lane);
        for (int m = gw; m < T; m += NGW) {
            const GAS f32x4* xr = (const GAS f32x4*)(x + (size_t)m * D) + F.lane; const GAS f32x4* gr = (const GAS f32x4*)g_mix + F.lane;
            f32x4 v[16]; float s = 0.f;
#pragma unroll
            for (int j = 0; j < 16; ++j) { v[j] = xr[64 * j]; s += (v[j][0] * v[j][0] + v[j][1] * v[j][1]) + (v[j][2] * v[j][2] + v[j][3] * v[j][3]); }
            const float r = 1.0f / sqrtf(wave_sum(s) * (1.0f / D) + EPS);
            GAS v2u* o8 = (GAS v2u*)(U + (size_t)m * D) + F.lane;
#pragma unroll
            for (int j = 0; j < 16; ++j) { const f32x4 gg = gr[64 * j]; v2u w; w.x = pk2(v[j][0] * r * gg[0], v[j][1] * r * gg[1]); w.y = pk2(v[j][2] * r * gg[2], v[j][3] * r * gg[3]); o8[64 * j] = w; }
        }
        if (BOTH(0)) GRID_BAR();
    }
    if (IN(1)) {
        pg8::Gemm g{U, WinT, T, NIN, D, D, D, 0, 0}; pg8::StaticOrder S; S.init(T, NIN, F.G, (int)blockIdx.x);
        EpiProj E{Zb, lb_param};
        pg8::gemm_phase<EpiProj, pg8::StaticOrder, true, true>(F.lds + RING_OFF, g, S, E);
        if (BOTH(1)) GRID_BAR();
    }
    if (IN(2)) {
        for (int it = gw; it < (T / 4) * 4; it += NGW) {
            const int t4 = (it >> 2) * 4, gi = it & 3, c8 = gi * 512 + F.lane * 8;
            if (gi == 0) pool_item<2>(Zb, Pb, t4, c8); else if (gi == 1) pool_item<4>(Zb, Pb, t4, c8); else if (gi == 2) pool_item<8>(Zb, Pb, t4, c8); else pool_item<16>(Zb, Pb, t4, c8);
        }
        for (int b = F.vcu; b < NH * 16; b += F.G)
            hgrn_pass<false>(F.lds + RING_OFF, b >> 4, b & 15, QSb, Gb, KKb, Vb, OGb, hgrn_norm, HU, HDt, HS, YH, F.tid, F.lane, F.wave);
        if (BOTH(2)) GRID_BAR();
    }
    if (IN(3)) {
        pg8::Gemm g{Pb, WpgT, T, PW, 512, PW, 512, 1, 512}; pg8::StaticOrder S; S.init(T, PW, F.G, (int)blockIdx.x);
        EpiScaleBf16 E{YP, PW, pool_scale};
        pg8::gemm_phase<EpiScaleBf16, pg8::StaticOrder, true, true>(F.lds + RING_OFF, g, S, E);
        for (int e = gt; e < NH * HD * HD; e += NGT) {
            const int h = e >> 14, kv = e & 16383, k = kv >> 7; float Sc = 0.f;
#pragma unroll
            for (int sc = 0; sc < 16; ++sc) { const size_t it = (size_t)(h * 16 + sc); HS[(it << 14) + kv] = Sc; Sc = HDt[it * 128 + k] * Sc + HU[(it << 14) + kv]; }
        }
        if (BOTH(3)) GRID_BAR();
    }
    if (IN(4)) {
        for (int b = F.vcu; b < NH * 16; b += F.G)
            hgrn_pass<true>(F.lds + RING_OFF, b >> 4, b & 15, QSb, Gb, KKb, Vb, OGb, hgrn_norm, HU, HDt, HS, YH, F.tid, F.lane, F.wave);
        { pg8::Gemm g{YP, WupT, T, D, PW, PW, PW, 0, 0}; pg8::StaticOrder S; S.init(T, D, F.G, (int)blockIdx.x);
          EpiGateF32 E{out, GAb};
          pg8::gemm_phase<EpiGateF32, pg8::StaticOrder, true, true>(F.lds + RING_OFF, g, S, E); }
        if (BOTH(4)) GRID_BAR();
    }
    if (IN(5)) {
        { pg8::Gemm g{YH, WuhT, T, D, HW, HW, HW, 0, 0}; pg8::StaticOrder S; S.init(T, D, F.G, (int)blockIdx.x);
          EpiGateAddBf16 E{out, GBb, MG};
          pg8::gemm_phase<EpiGateAddBf16, pg8::StaticOrder, true, true>(F.lds + RING_OFF, g, S, E); }
        if (BOTH(5)) GRID_BAR();
    }
    if (IN(6)) {
        pg8::Gemm g{MG, WoT, T, D, D, D, D, 0, 0}; pg8::StaticOrder S; S.init(T, D, F.G, (int)blockIdx.x);
        EpiResid<true> E{x, out, H1B, g_ffn, SSQ1};
        pg8::gemm_phase<EpiResid<true>, pg8::StaticOrder, true, true>(F.lds + RING_OFF, g, S, E);
        if (BOTH(6)) GRID_BAR();
    }
    if (IN(7)) {
    }
    if (IN(8)) {
        pg8::Gemm g{H1B, WguT, T, 2 * DFF, D, D, D, 0, 0}; pg8::StaticOrder S; S.init(T, 2 * DFF, F.G, (int)blockIdx.x);
        LAS float* rsl = (LAS float*)(F.lds + RS_OFF);
        { pg8::Unit u0; int pm_lo = 1 << 30, pm_hi = -1;
          for (int i = 0; S.next(i, u0); ++i) { pm_lo = u0.pm < pm_lo ? u0.pm : pm_lo; pm_hi = u0.pm > pm_hi ? u0.pm : pm_hi; }
          for (int pmx = pm_lo; pmx <= pm_hi && pmx < pm_lo + RS_PANELS; ++pmx)
              for (int r = F.tid; r < 256; r += NWAVES * 64) { float sq = 0.f;
#pragma unroll 8
                  for (int p = 0; p < 64; ++p) sq += SSQ1[(size_t)p * T + pmx * 256 + r];
                  rsl[(pmx - pm_lo) * 256 + r] = 1.0f / sqrtf(sq * (1.0f / D) + EPS); }
          __syncthreads();
          EpiSwiGLU E{ACT, rsl, pm_lo};
          pg8::gemm_phase<EpiSwiGLU, pg8::StaticOrder, true, true>(F.lds + RING_OFF, g, S, E); }
        if (BOTH(8)) GRID_BAR();
    }
    if (IN(9)) {
        pg8::Gemm g{ACT, WdT, T, D, DFF, DFF, DFF, 0, 0}; pg8::StaticOrder S; S.init(T, D, F.G, (int)blockIdx.x);
        EpiResid<false> E{out, out, nullptr, nullptr, SSQ2};
        pg8::gemm_phase<EpiResid<false>, pg8::StaticOrder, true, true>(F.lds + RING_OFF, g, S, E);
        if (BOTH(9)) GRID_BAR();
    }
    if (IN(10)) {
        for (int m = gw; m < T; m += NGW) {
            const float r = 1.0f / sqrtf(wave_sum(SSQ2[(size_t)F.lane * T + m]) * (1.0f / D) + EPS);
            GAS f32x4* orow = (GAS f32x4*)(out + (size_t)m * D) + F.lane; const GAS f32x4* gr = (const GAS f32x4*)g_final + F.lane;
#pragma unroll
            for (int j = 0; j < 16; ++j) { const f32x4 v = orow[64 * j]; const f32x4 gg = gr[64 * j]; orow[64 * j] = v * r * gg; }
        }
    }
#if PROBE_DUP >= 11
    if (IN(11)) {
        pg8::Gemm g{U, WinT, T, NIN, D, D, D, 0, 0}; pg8::StaticOrder S; S.init(T, NIN, F.G, (int)blockIdx.x);
        EpiNull E{};
        pg8::gemm_phase<EpiNull, pg8::StaticOrder, true, true>(F.lds + RING_OFF, g, S, E);
    }
    if (IN(12)) {
        pg8::Gemm g{ACT, WdT, T, D, DFF, DFF, DFF, 0, 0}; pg8::StaticOrder S; S.init(T, D, F.G, (int)blockIdx.x);
        EpiNull E{};
        pg8::gemm_phase<EpiNull, pg8::StaticOrder, true, true>(F.lds + RING_OFF, g, S, E);
    }
#endif
#undef IN
#undef BOTH
#undef GRID_BAR
}

extern "C" void kernel_launch(void* const* d_in, const int* in_sizes, int n_in, void* d_out, int out_size, void* d_ws, size_t ws_size, hipStream_t stream) {
    static int grid = 0;
    if (grid == 0) {
        if (n_in != 15 || in_sizes[0] != T * D || out_size != T * D || ws_size < WS_END) { fprintf(stderr, "kernel_launch: unexpected shapes: n_in %d in0 %d out %d ws %zu (need %zu)\n", n_in, n_in > 0 ? in_sizes[0] : -1, out_size, ws_size, (size_t)WS_END); grid = -1; return; }
        int dev = 0, cus = 0, per_cu = 0;
        if (hipGetDevice(&dev) != hipSuccess || hipDeviceGetAttribute(&cus, hipDeviceAttributeMultiprocessorCount, dev) != hipSuccess) { grid = -1; return; }
        if (hipFuncSetAttribute((const void*)fwd, hipFuncAttributeMaxDynamicSharedMemorySize, LDS_BYTES) != hipSuccess) { fprintf(stderr, "kernel_launch: hipFuncSetAttribute failed\n"); grid = -1; return; }
        if (hipOccupancyMaxActiveBlocksPerMultiprocessor(&per_cu, (const void*)fwd, NWAVES * 64, LDS_BYTES) != hipSuccess || per_cu < 1) fprintf(stderr, "kernel_launch: occupancy query says %d\n", per_cu);
        (void)hipGetLastError();
        grid = cus;
    }
    if (grid < 0) return;
    if (hipMemsetAsync((char*)d_ws + WS_CTL, 0, CTL_ZERO_BYTES, stream) != hipSuccess) return;
    Args a{};
    for (int i = 0; i < 15; ++i) a.in[i] = (const float*)d_in[i];
    a.out = (float*)d_out; a.ws = (unsigned char*)d_ws;
    for (int li = 0; li < N_LAUNCHES; ++li) {
        a.ph_lo = (N_LAUNCHES == NPHASE) ? li : 0; a.ph_hi = (N_LAUNCHES == NPHASE) ? li + 1 : NPHASE; a.li = li;
        hipLaunchKernelGGL(fwd, dim3(grid), dim3(NWAVES * 64), LDS_BYTES, stream, a);
        const hipError_t le = hipPeekAtLastError();
        if (le != hipSuccess) { fprintf(stderr, "kernel_launch: launch %d failed: %s\n", li, hipGetErrorName(le)); break; }
    }
    if (N_LAUNCHES == NPHASE && PROBE_DUP >= 0) {
        a.ph_lo = PROBE_DUP; a.ph_hi = PROBE_DUP + 1; a.li = 0;
        for (int rep = 0; rep < PROBE_REPS; ++rep) hipLaunchKernelGGL(fwd, dim3(grid), dim3(NWAVES * 64), LDS_BYTES, stream, a);
    }
}
```

```cpp
#include <hip/hip_runtime.h>
#include <cstdio>
#include <cstdint>

#ifndef PROBE_DUP
#define PROBE_DUP -1
#endif
#ifndef PROBE_REPS
#define PROBE_REPS 1
#endif
#ifndef MK_N_LAUNCHES
#define MK_N_LAUNCHES 1
#endif

namespace pg8 {
#define PG8_LAS __attribute__((address_space(3)))
typedef unsigned short bf16_t;
typedef short bf16x8 __attribute__((ext_vector_type(8)));
typedef float f32x4 __attribute__((ext_vector_type(4)));
typedef unsigned u32x4 __attribute__((ext_vector_type(4)));
typedef unsigned u32x2 __attribute__((ext_vector_type(2)));
constexpr int BM = 256, BK = 64, HALF = 128, HTB = HALF * BK * 2  , STAGE_BYTES = 8 * HTB, NXCD = 8, WGM = 8;

__host__ __device__ __forceinline__ int lds_byte(int r, int c) { const int st = (r >> 4) * 2 + (c >> 5), rr = r & 15, cc = c & 31, ob = rr * 64 + cc * 2; return st * 1024 + (ob ^ (((ob >> 9) & 1) << 5)); }
__host__ __device__ __forceinline__ void stage_rc(int b, int& R, int& C) { const int st = b / 1024, sb = b % 1024, swz = sb ^ (((sb >> 9) & 1) << 5); R = (st >> 1) * 16 + swz / 64; C = (st & 1) * 32 + (swz % 64) / 2; }
__host__ __device__ __forceinline__ int perm32(int rho) { const int n = rho >> 4, i = rho & 15; return 8 * (i >> 2) + 4 * n + (i & 3); }

struct Unit { int pm, pn; };
struct Gemm { const bf16_t* A; const bf16_t* Bt; int M, N, K, lda, ldb, agrp_shift, agrp_stride; };

struct StaticOrder {
    int nM, nN, nwg, G, c;
    __host__ __device__ void init(int M, int N, int G_, int c_) { nM = M / BM; nN = N / BM; nwg = nM * nN; G = G_; c = c_; }
    __host__ __device__ bool next(int i, Unit& u) const {
        const long L = (long)i * G + c; if (L >= nwg) return false;
        int wgid = (int)L; { const int q = nwg / NXCD, r = nwg % NXCD, xcd = wgid % NXCD, off = wgid / NXCD; wgid = (xcd < r ? xcd * (q + 1) : r * (q + 1) + (xcd - r) * q) + off; }
        const int nig = WGM * nN, gid = wgid / nig, fm = gid * WGM, gsz = (nM - fm) < WGM ? (nM - fm) : WGM;
        u.pm = fm + ((wgid % nig) % gsz); u.pn = (wgid % nig) / gsz; return true;
    }
    __device__ __forceinline__ void a_ready(const Unit&) const {}
    __device__ __forceinline__ void done(const Unit&) const {}
};

__device__ __forceinline__ unsigned cvt_pk_bf16(float lo, float hi) { unsigned r; asm volatile("v_cvt_pk_bf16_f32 %0, %1, %2" : "=v"(r) : "v"(lo), "v"(hi)); return r; }
__device__ __forceinline__ float bf_lo(unsigned w) { return __uint_as_float(w << 16); }
__device__ __forceinline__ float bf_hi(unsigned w) { return __uint_as_float(w & 0xffff0000u); }
__device__ __forceinline__ float fsigmoid(float x) { return __builtin_amdgcn_rcpf(1.0f + __expf(-x)); }
__device__ __forceinline__ float fsilu(float x) { return x * fsigmoid(x); }

template <class Epi, class Sched, bool ALIGN_EPI = false, bool SP2 = false>
__device__ __forceinline__ void gemm_phase(PG8_LAS unsigned char* lds, const Gemm g, const Sched& S, const Epi& E) {
    const int tid = threadIdx.x, wid = __builtin_amdgcn_readfirstlane(tid >> 6), lane = tid & 63, wr = wid >> 2, wc = wid & 3, fr = lane & 15, fq = lane >> 4;
    const int K = g.K, nt = K / BK;
    unsigned voffA[2], voffB[2];
#pragma unroll
    for (int i = 0; i < 2; ++i) { int R, C; stage_rc(tid * 16 + i * 8192, R, C); const int Rb = Epi::PERM ? ((R & ~31) + perm32(R & 31)) : R;
        voffA[i] = (unsigned)(R * g.lda + C) * 2u; voffB[i] = (unsigned)(Rb * g.ldb + C) * 2u; }
    const size_t kstep = (size_t)(BK * 2);
    const size_t hstepA = (size_t)HALF * g.lda * 2, hstepB = (size_t)HALF * g.ldb * 2;
    const size_t tstepA = 2 * hstepA, tstepB = 2 * hstepB;
    const unsigned ldsw = (unsigned)wid * 1024u;
    const int aoff = lds_byte(wr * 64 + fr, fq * 8), boff = lds_byte(wc * 32 + fr, fq * 8);
#define PG8_SA(b, h) (((b) * 2 + (h)) * HTB)
#define PG8_SB(b, h) ((4 + (b) * 2 + (h)) * HTB)
#define PG8_STAGE(bufoff, gbase, voff) do { _Pragma("unroll") for (int _i = 0; _i < 2; ++_i) \
        __builtin_amdgcn_global_load_lds((const unsigned*)((const char*)(gbase) + (voff)[_i]), (PG8_LAS unsigned*)(lds + (bufoff) + ldsw + _i * 8192), 16, 0, 0); } while (0)
#define PG8_LDA(dst, b, h) do { _Pragma("unroll") for (int m = 0; m < 4; ++m) _Pragma("unroll") for (int k = 0; k < 2; ++k) dst[m][k] = *(const PG8_LAS bf16x8*)(lds + PG8_SA(b, h) + aoff + m * 2048 + k * 1024); } while (0)
#define PG8_LDB(dst, b, h) do { _Pragma("unroll") for (int n = 0; n < 2; ++n) _Pragma("unroll") for (int k = 0; k < 2; ++k) dst[n][k] = *(const PG8_LAS bf16x8*)(lds + PG8_SB(b, h) + boff + n * 2048 + k * 1024); } while (0)
#define PG8_MMA(ai, bj, At, Bt) do { __builtin_amdgcn_s_setprio(1); _Pragma("unroll") for (int m = 0; m < 4; ++m) _Pragma("unroll") for (int n = 0; n < 2; ++n) _Pragma("unroll") for (int k = 0; k < 2; ++k) \
        acc[ai][bj][m][n] = __builtin_amdgcn_mfma_f32_16x16x32_bf16(Bt[n][k], At[m][k], acc[ai][bj][m][n], 0, 0, 0); __builtin_amdgcn_s_setprio(0); } while (0)
#define PG8_WAIT_V(n) asm volatile("s_waitcnt vmcnt(" #n ")" ::: "memory")
#define PG8_WAIT_L(n) asm volatile("s_waitcnt lgkmcnt(" #n ")" ::: "memory")
#define PG8_BAR __builtin_amdgcn_s_barrier()
#define PG8_SCHED __builtin_amdgcn_sched_barrier(0)
#define PG8_ABASE(u) ((const char*)g.A + (size_t)(u).pm * tstepA + (g.agrp_stride ? (size_t)(((u).pn >> g.agrp_shift) * g.agrp_stride) * 2 : (size_t)0))
    Unit cur, nxt; int ui = 0;
    if (!S.next(0, cur)) return;
    f32x4 acc[2][2][4][2];
#pragma unroll
    for (int a = 0; a < 2; ++a)
#pragma unroll
        for (int b = 0; b < 2; ++b)
#pragma unroll
            for (int m = 0; m < 4; ++m)
#pragma unroll
                for (int n = 0; n < 2; ++n) acc[a][b][m][n] = (f32x4){0.f, 0.f, 0.f, 0.f};
    bf16x8 At[4][2], B0[2][2], B1[2][2];
    const char* cA = PG8_ABASE(cur); const char* cB = (const char*)g.Bt + (size_t)cur.pn * tstepB;
    S.a_ready(cur);
    if constexpr (SP2) {
        PG8_STAGE(PG8_SB(0, 0), cB, voffB); PG8_STAGE(PG8_SB(0, 1), cB + hstepB, voffB); PG8_STAGE(PG8_SA(0, 0), cA, voffA); PG8_STAGE(PG8_SA(0, 1), cA + hstepA, voffA);
        if (wr == 1) PG8_BAR;
        PG8_WAIT_V(2); PG8_BAR;
        PG8_STAGE(PG8_SB(1, 0), cB + kstep, voffB); PG8_STAGE(PG8_SA(1, 0), cA + kstep, voffA); PG8_STAGE(PG8_SB(1, 1), cB + hstepB + kstep, voffB);
        PG8_WAIT_V(6); PG8_BAR;
    } else {
        PG8_STAGE(PG8_SB(0, 0), cB, voffB); PG8_STAGE(PG8_SA(0, 0), cA, voffA); PG8_STAGE(PG8_SB(0, 1), cB + hstepB, voffB); PG8_STAGE(PG8_SA(0, 1), cA + hstepA, voffA);
        if (wr == 1) PG8_BAR;
        PG8_WAIT_V(4); PG8_BAR;
        PG8_STAGE(PG8_SB(1, 0), cB + kstep, voffB); PG8_STAGE(PG8_SA(1, 0), cA + kstep, voffA); PG8_STAGE(PG8_SB(1, 1), cB + hstepB + kstep, voffB);
        PG8_WAIT_V(6); PG8_BAR;
    }
    for (;;) {
        const bool has_next = S.next(ui + 1, nxt);
        const char* nA = has_next ? PG8_ABASE(nxt) : cA; const char* nB = has_next ? (const char*)g.Bt + (size_t)nxt.pn * tstepB : cB;
        for (int t = 0; t < nt; t += 2) {
            const bool last = (t == nt - 2);
            const char* a1 = cA + (size_t)(t + 1) * kstep;
            const char* a2 = last ? nA : cA + (size_t)(t + 2) * kstep; const char* b2 = last ? nB : cB + (size_t)(t + 2) * kstep;
            const char* a3 = a2 + kstep; const char* b3 = b2 + kstep;
            if (last && has_next) S.a_ready(nxt);
            if constexpr (SP2) {
            PG8_LDB(B0, 0, 0); PG8_LDB(B1, 0, 1); PG8_SCHED; PG8_LDA(At, 0, 0); PG8_STAGE(PG8_SA(1, 1), a1 + hstepA, voffA);
            PG8_WAIT_V(8); PG8_WAIT_L(0); PG8_BAR; PG8_MMA(0, 0, At, B0); PG8_MMA(0, 1, At, B1); PG8_BAR; PG8_SCHED;
            PG8_LDA(At, 0, 1); PG8_STAGE(PG8_SB(0, 0), b2, voffB); PG8_STAGE(PG8_SB(0, 1), b2 + hstepB, voffB); PG8_STAGE(PG8_SA(0, 0), a2, voffA);
            PG8_WAIT_V(8); PG8_WAIT_L(0); PG8_BAR; PG8_MMA(1, 0, At, B0); PG8_MMA(1, 1, At, B1); PG8_BAR; PG8_SCHED;
            PG8_LDB(B0, 1, 0); PG8_LDB(B1, 1, 1); PG8_SCHED; PG8_LDA(At, 1, 0); PG8_STAGE(PG8_SA(0, 1), a2 + hstepA, voffA);
            PG8_WAIT_V(8); PG8_WAIT_L(0); PG8_BAR; PG8_MMA(0, 0, At, B0); PG8_MMA(0, 1, At, B1); PG8_BAR; PG8_SCHED;
            PG8_LDA(At, 1, 1); PG8_STAGE(PG8_SB(1, 0), b3, voffB); PG8_STAGE(PG8_SB(1, 1), b3 + hstepB, voffB); PG8_STAGE(PG8_SA(1, 0), a3, voffA);
            PG8_WAIT_V(8); PG8_WAIT_L(0); PG8_BAR; PG8_MMA(1, 0, At, B0); PG8_MMA(1, 1, At, B1); PG8_BAR; PG8_SCHED;
            } else {
            PG8_LDB(B0, 0, 0); PG8_SCHED; PG8_LDA(At, 0, 0); PG8_STAGE(PG8_SA(1, 1), a1 + hstepA, voffA);
            PG8_WAIT_L(8); PG8_BAR; PG8_WAIT_L(0); PG8_MMA(0, 0, At, B0); PG8_BAR; PG8_SCHED;
            PG8_LDB(B1, 0, 1); PG8_STAGE(PG8_SB(0, 0), b2, voffB);
            PG8_BAR; PG8_WAIT_L(0); PG8_MMA(0, 1, At, B1); PG8_BAR;
            PG8_LDA(At, 0, 1); PG8_STAGE(PG8_SA(0, 0), a2, voffA);
            PG8_BAR; PG8_WAIT_L(0); PG8_MMA(1, 0, At, B0); PG8_BAR; PG8_SCHED;
            PG8_STAGE(PG8_SB(0, 1), b2 + hstepB, voffB);
            PG8_WAIT_V(6); PG8_BAR; PG8_MMA(1, 1, At, B1); PG8_BAR;
            PG8_LDB(B0, 1, 0); PG8_SCHED; PG8_LDA(At, 1, 0); PG8_STAGE(PG8_SA(0, 1), a2 + hstepA, voffA);
            PG8_WAIT_L(8); PG8_BAR; PG8_WAIT_L(0); PG8_MMA(0, 0, At, B0); PG8_BAR; PG8_SCHED;
            PG8_LDB(B1, 1, 1); PG8_STAGE(PG8_SB(1, 0), b3, voffB);
            PG8_BAR; PG8_WAIT_L(0); PG8_MMA(0, 1, At, B1); PG8_BAR;
            PG8_LDA(At, 1, 1); PG8_STAGE(PG8_SA(1, 0), a3, voffA);
            PG8_BAR; PG8_WAIT_L(0); PG8_MMA(1, 0, At, B0); PG8_BAR; PG8_SCHED;
            PG8_STAGE(PG8_SB(1, 1), b3 + hstepB, voffB);
            PG8_WAIT_V(6); PG8_BAR; PG8_MMA(1, 1, At, B1); PG8_BAR;
            }
        }
        if constexpr (ALIGN_EPI) { if (wr == 0) PG8_BAR; }
        E(acc, cur, wr, wc, fr, fq); S.done(cur);
        if (!has_next) break;
#pragma unroll
        for (int a = 0; a < 2; ++a)
#pragma unroll
            for (int b = 0; b < 2; ++b)
#pragma unroll
                for (int m = 0; m < 4; ++m)
#pragma unroll
                    for (int n = 0; n < 2; ++n) acc[a][b][m][n] = (f32x4){0.f, 0.f, 0.f, 0.f};
        cur = nxt; cA = nA; cB = nB; ++ui;
        if constexpr (ALIGN_EPI) { if (wr == 1) PG8_BAR; }
    }
    PG8_WAIT_V(0);
    if constexpr (!ALIGN_EPI) { if (wr == 0) PG8_BAR; }
    PG8_BAR;
#undef PG8_ABASE
#undef PG8_SA
#undef PG8_SB
#undef PG8_STAGE
#undef PG8_LDA
#undef PG8_LDB
#undef PG8_MMA
#undef PG8_WAIT_V
#undef PG8_WAIT_L
#undef PG8_BAR
#undef PG8_SCHED
}
}

constexpr int NWAVES = 8;
constexpr int T = 8192, D = 4096, PW = 2048, HW = 2048, NH = 16, HD = 128, DFF = 11008;
constexpr int NIN = PW + 4 * HW + 2 * D;
constexpr float EPS = 1e-6f;
constexpr int NPHASE = 11;
constexpr int N_LAUNCHES = MK_N_LAUNCHES;

constexpr size_t MiB = 1u << 20;
constexpr size_t WS_CTL = 0, CTL_ZERO_BYTES = 1 * MiB;
constexpr size_t WS_WIN = 1 * MiB;
constexpr size_t WS_WPG = WS_WIN + 144 * MiB;
constexpr size_t WS_WUP = WS_WPG + 2 * MiB;
constexpr size_t WS_WUH = WS_WUP + 16 * MiB;
constexpr size_t WS_WO = WS_WUH + 16 * MiB;
constexpr size_t WS_WGU = WS_WO + 32 * MiB;
constexpr size_t WS_WD = WS_WGU + 172 * MiB;
constexpr size_t WS_U = WS_WD + 86 * MiB;
constexpr size_t WS_PROJ = WS_U + 64 * MiB;
constexpr size_t WS_Z = WS_PROJ, WS_QS = WS_Z + 32 * MiB, WS_G = WS_QS + 32 * MiB, WS_KK = WS_G + 32 * MiB, WS_V = WS_KK + 32 * MiB, WS_OG = WS_V + 32 * MiB;
constexpr size_t WS_GA = WS_OG + 32 * MiB, WS_GB = WS_GA + 64 * MiB;
constexpr size_t WS_ACT = WS_PROJ;
constexpr size_t WS_P = WS_PROJ + 320 * MiB;
constexpr size_t WS_YP = WS_P + 32 * MiB, WS_YH = WS_YP + 32 * MiB;
constexpr size_t WS_H1B = WS_YH + 32 * MiB;
constexpr size_t WS_O = WS_H1B + 64 * MiB;
constexpr size_t WS_HU = WS_O, WS_HS = WS_O + 16 * MiB, WS_HD = WS_O + 32 * MiB;
constexpr size_t WS_SSQ1 = WS_O + 64 * MiB, WS_SSQ2 = WS_SSQ1 + 2 * MiB, WS_RS1 = WS_SSQ2 + 2 * MiB;
constexpr size_t WS_END = WS_RS1 + 1 * MiB;
static_assert(WS_ACT + (size_t)T * DFF * 2 <= WS_P, "ACT overlay fits the projection region");

constexpr int RING_OFF = 0, RING_BYTES = 131072;
constexpr int LDSCTL_OFF = RING_BYTES, MISC_OFF = LDSCTL_OFF + 320;
constexpr int RS_OFF = LDSCTL_OFF + 1024, RS_PANELS = 8;
constexpr int LDS_BYTES = 147456;
static_assert(MISC_OFF + 128 <= RS_OFF && RS_OFF + RS_PANELS * 1024 <= LDS_BYTES, "LDS map");

#define GAS __attribute__((address_space(1)))
#define LAS __attribute__((address_space(3)))
typedef unsigned short bf16;
typedef unsigned v4u __attribute__((ext_vector_type(4)));
typedef unsigned v2u __attribute__((ext_vector_type(2)));
typedef float f32x4 __attribute__((ext_vector_type(4)));
typedef GAS unsigned gu32;
#define RLX_AGENT __ATOMIC_RELAXED, __HIP_MEMORY_SCOPE_AGENT
#define LDS_WAIT() asm volatile("s_waitcnt lgkmcnt(0)" ::: "memory")
#define VM_WAIT() asm volatile("s_waitcnt vmcnt(0)" ::: "memory")
__device__ __forceinline__ unsigned f2bf(float f) { unsigned u = __builtin_bit_cast(unsigned, f); return (u + 0x7fffu + ((u >> 16) & 1u)) >> 16; }
__device__ __forceinline__ unsigned pk2(float lo, float hi) { return f2bf(lo) | (f2bf(hi) << 16); }
__device__ __forceinline__ float bf2f(unsigned short b) { return __uint_as_float(((unsigned)b) << 16); }

#define XB_TMO      128
#define XB_XCNT(j)  (256  + 64 * (j))
#define XB_XSUB(j)  (1280 + 64 * (j))
#define XB_XGEN(j)  (2304 + 64 * (j))
#define XB_TOP      3328
#define XB_TOPGEN   3392
#define XCD_BAR_WORDS 3456
#define XB_SPIN_CAP (1u << 18)
__device__ __forceinline__ unsigned xb_ld(unsigned* p)              { return __hip_atomic_load(p, __ATOMIC_RELAXED, __HIP_MEMORY_SCOPE_AGENT); }
__device__ __forceinline__ unsigned xb_add(unsigned* p, unsigned v) { return __hip_atomic_fetch_add(p, v, __ATOMIC_RELAXED, __HIP_MEMORY_SCOPE_AGENT); }
__device__ __forceinline__ unsigned xb_xcc_id() { return (unsigned)__builtin_amdgcn_s_getreg((3 << 11) | 20) & 0xFu; }
#define XB_SPIN(cond, bar) do { unsigned _sp = 0; while (cond) { __builtin_amdgcn_s_sleep(1); \
    if ((++_sp & 255u) == 0u) { if (xb_ld(&(bar)[XB_TMO])) break; if (_sp > XB_SPIN_CAP) { atomicAdd(&(bar)[XB_TMO], 1u); break; } } } } while (0)
struct XcdBarrier { unsigned* bar; unsigned x; volatile LAS unsigned* st; };
__device__ __forceinline__ XcdBarrier xcd_barrier_post(unsigned* bar, volatile LAS unsigned* st) {
    XcdBarrier b; b.bar = bar; b.x = xb_xcc_id(); b.st = st;
    if (threadIdx.x == 0) (void)xb_add(&bar[XB_XCNT(b.x)], 1u);
    return b;
}
__device__ __forceinline__ void xcd_barrier_complete(unsigned* bar, unsigned x, unsigned& nloc, unsigned& nx) {
    const unsigned G = gridDim.x * gridDim.y * gridDim.z;
    unsigned sum, cnt, mine, sp = 0u;
    for (;;) {
        sum = 0u; cnt = 0u; mine = 0u;
#pragma unroll
        for (unsigned j = 0; j < 16; ++j) { const unsigned c = xb_ld(&bar[XB_XCNT(j)]); sum += c; cnt += (c > 0u) ? 1u : 0u; mine = (j == x) ? c : mine; }
        if (sum == G) break;
        __builtin_amdgcn_s_sleep(1);
        if ((++sp & 255u) == 0u) { if (xb_ld(&bar[XB_TMO])) break; if (sp > XB_SPIN_CAP) { atomicAdd(&bar[XB_TMO], 1u); break; } }
    }
    nloc = mine > 0u ? mine : 1u; nx = cnt > 0u ? cnt : 1u;
}
__device__ __forceinline__ void xcd_barrier(const XcdBarrier& b) {
    asm volatile("s_waitcnt vmcnt(0)" ::: "memory");
    __syncthreads();
    if (threadIdx.x == 0) {
        unsigned* bar = b.bar;
        __builtin_amdgcn_s_waitcnt(0);
        unsigned nloc = b.st[0], nx = b.st[1];
        if (nloc == 0u) { xcd_barrier_complete(bar, b.x, nloc, nx); b.st[0] = nloc; b.st[1] = nx; }
        const unsigned old = xb_add(&bar[XB_XSUB(b.x)], 1u);
        const unsigned gen = old / nloc;
        if (old + 1u == (gen + 1u) * nloc) {
            __builtin_amdgcn_fence(__ATOMIC_RELEASE, "agent");
            asm volatile("s_waitcnt vmcnt(0)" ::: "memory");
            const unsigned og = xb_add(&bar[XB_TOP], 1u);
            const unsigned tg = og / nx;
            if (og + 1u == (tg + 1u) * nx) xb_add(&bar[XB_TOPGEN], 1u);
            else XB_SPIN(xb_ld(&bar[XB_TOPGEN]) == tg, bar);
            __builtin_amdgcn_fence(__ATOMIC_ACQUIRE, "agent");
            xb_add(&bar[XB_XGEN(b.x)], 1u);
            asm volatile("s_waitcnt vmcnt(0)" ::: "memory");
        } else {
            XB_SPIN(xb_ld(&bar[XB_XGEN(b.x)]) == gen, bar);
            __builtin_amdgcn_fence(__ATOMIC_ACQUIRE, "agent");
            asm volatile("s_waitcnt vmcnt(0)" ::: "memory");
        }
    }
    __syncthreads();
}

using pg8::Unit; using pg8::cvt_pk_bf16; using pg8::fsigmoid; using pg8::fsilu; using pg8::bf_lo; using pg8::bf_hi;
constexpr int BM = 256, HALF = 128;

struct EpiProj {
    static constexpr bool PERM = true;
    bf16* PROJ; const float* lbp;
    __device__ __forceinline__ void operator()(const f32x4 (&acc)[2][2][4][2], const Unit& u, int wr, int wc, int fr, int fq) const {
        const int row0 = u.pm * BM + wr * 64 + fr; const int cls = u.pn >> 3;
        int ldc, colt; size_t toff;
        if (cls < 5) { ldc = 2048; colt = (u.pn & 7) * 256; toff = (size_t)(cls + (cls >= 3 ? 1 : 0)) * ((size_t)T * 2048); }
        else { ldc = 4096; colt = (u.pn - (cls < 7 ? 40 : 56)) * 256; toff = (size_t)6 * ((size_t)T * 2048) + (cls < 7 ? (size_t)0 : (size_t)T * 4096); }
        bf16* base = PROJ + toff; bf16* G = PROJ + (size_t)2 * T * 2048; bf16* KK = PROJ + (size_t)3 * T * 2048;
        const int col0 = colt + wc * 32 + 8 * fq;
        if (cls == 2) {
            float lb[2][8];
#pragma unroll
            for (int bj = 0; bj < 2; ++bj) {
                const f32x4 p0a = *(const f32x4*)(lbp + col0 + bj * HALF), p0b = *(const f32x4*)(lbp + col0 + bj * HALF + 4);
                const f32x4 p1a = *(const f32x4*)(lbp + HW + col0 + bj * HALF), p1b = *(const f32x4*)(lbp + HW + col0 + bj * HALF + 4);
#pragma unroll
                for (int j = 0; j < 4; ++j) { lb[bj][j] = __builtin_amdgcn_rcpf(1.0f + __expf(p1a[j] - p0a[j])); lb[bj][4 + j] = __builtin_amdgcn_rcpf(1.0f + __expf(p1b[j] - p0b[j])); }
            }
#pragma unroll
            for (int ai = 0; ai < 2; ++ai)
#pragma unroll
                for (int m = 0; m < 4; ++m) { const size_t ro = (size_t)(row0 + ai * HALF + m * 16) * 2048 + col0;
#pragma unroll
                    for (int bj = 0; bj < 2; ++bj) { float gl[8], kv[8];
#pragma unroll
                        for (int n = 0; n < 2; ++n)
#pragma unroll
                            for (int j = 0; j < 4; ++j) { const float x = fminf(fmaxf(acc[ai][bj][m][n][j], -80.f), 80.f); const float e = __expf(-x); const float sg = __builtin_amdgcn_rcpf(1.0f + e); const float l = lb[bj][4 * n + j];
                                const float f = l + (1.0f - l) * sg; gl[4 * n + j] = __logf(f); kv[4 * n + j] = (1.0f - l) * (e * sg); }
                        pg8::u32x4 w; w.x = cvt_pk_bf16(gl[0], gl[1]); w.y = cvt_pk_bf16(gl[2], gl[3]); w.z = cvt_pk_bf16(gl[4], gl[5]); w.w = cvt_pk_bf16(gl[6], gl[7]);
                        *(pg8::u32x4*)(G + ro + bj * HALF) = w;
                        w.x = cvt_pk_bf16(kv[0], kv[1]); w.y = cvt_pk_bf16(kv[2], kv[3]); w.z = cvt_pk_bf16(kv[4], kv[5]); w.w = cvt_pk_bf16(kv[6], kv[7]);
                        *(pg8::u32x4*)(KK + ro + bj * HALF) = w; } }
            return;
        }
        const int act = (cls == 0 || cls == 3) ? 0 : (cls == 1 || cls == 4) ? 1 : 2;
#pragma unroll
        for (int ai = 0; ai < 2; ++ai)
#pragma unroll
            for (int m = 0; m < 4; ++m) { bf16* rowp = base + (size_t)(row0 + ai * HALF + m * 16) * ldc + col0;
#pragma unroll
                for (int bj = 0; bj < 2; ++bj) { f32x4 v0 = acc[ai][bj][m][0], v1 = acc[ai][bj][m][1];
                    if (act != 0) {
#pragma unroll
                        for (int j = 0; j < 4; ++j) { const float s0 = fsigmoid(v0[j]), s1 = fsigmoid(v1[j]); v0[j] = act == 1 ? v0[j] * s0 : s0; v1[j] = act == 1 ? v1[j] * s1 : s1; } }
                    pg8::u32x4 w; w.x = cvt_pk_bf16(v0[0], v0[1]); w.y = cvt_pk_bf16(v0[2], v0[3]); w.z = cvt_pk_bf16(v1[0], v1[1]); w.w = cvt_pk_bf16(v1[2], v1[3]);
                    *(pg8::u32x4*)(rowp + bj * HALF) = w; } }
    }
};
struct EpiScaleBf16 {
    static constexpr bool PERM = true;
    bf16* O; int ldc; const float* scale;
    __device__ __forceinline__ void operator()(const f32x4 (&acc)[2][2][4][2], const Unit& u, int wr, int wc, int fr, int fq) const {
        const int row0 = u.pm * BM + wr * 64 + fr, col0 = u.pn * BM + wc * 32 + 8 * fq;
        f32x4 sv[2][2];
#pragma unroll
        for (int bj = 0; bj < 2; ++bj)
#pragma unroll
            for (int n = 0; n < 2; ++n) sv[bj][n] = *(const f32x4*)(scale + col0 + bj * HALF + 4 * n);
#pragma unroll
        for (int ai = 0; ai < 2; ++ai)
#pragma unroll
            for (int m = 0; m < 4; ++m) { bf16* rowp = O + (size_t)(row0 + ai * HALF + m * 16) * ldc + col0;
#pragma unroll
                for (int bj = 0; bj < 2; ++bj) { const f32x4 v0 = acc[ai][bj][m][0] * sv[bj][0], v1 = acc[ai][bj][m][1] * sv[bj][1];
                    pg8::u32x4 w; w.x = cvt_pk_bf16(v0[0], v0[1]); w.y = cvt_pk_bf16(v0[2], v0[3]); w.z = cvt_pk_bf16(v1[0], v1[1]); w.w = cvt_pk_bf16(v1[2], v1[3]);
                    *(pg8::u32x4*)(rowp + bj * HALF) = w; } }
    }
};
struct EpiGateF32 {
    static constexpr bool PERM = true;
    float* X; const bf16* GT;
    __device__ __forceinline__ void operator()(const f32x4 (&acc)[2][2][4][2], const Unit& u, int wr, int wc, int fr, int fq) const {
        const int row0 = u.pm * BM + wr * 64 + fr, col0 = u.pn * BM + wc * 32 + 8 * fq;
#pragma unroll
        for (int ai = 0; ai < 2; ++ai)
#pragma unroll
            for (int m = 0; m < 4; ++m) { const size_t ro = (size_t)(row0 + ai * HALF + m * 16) * D + col0;
#pragma unroll
                for (int bj = 0; bj < 2; ++bj) { const pg8::u32x4 gw = *(const pg8::u32x4*)(GT + ro + bj * HALF);
                    f32x4 v0 = acc[ai][bj][m][0], v1 = acc[ai][bj][m][1];
                    v0[0] *= bf_lo(gw.x); v0[1] *= bf_hi(gw.x); v0[2] *= bf_lo(gw.y); v0[3] *= bf_hi(gw.y);
                    v1[0] *= bf_lo(gw.z); v1[1] *= bf_hi(gw.z); v1[2] *= bf_lo(gw.w); v1[3] *= bf_hi(gw.w);
                    *(f32x4*)(X + ro + bj * HALF) = v0; *(f32x4*)(X + ro + bj * HALF + 4) = v1; } }
    }
};
struct EpiGateAddBf16 {
    static constexpr bool PERM = true;
    const float* X; const bf16* GT; bf16* O;
    __device__ __forceinline__ void operator()(const f32x4 (&acc)[2][2][4][2], const Unit& u, int wr, int wc, int fr, int fq) const {
        const int row0 = u.pm * BM + wr * 64 + fr, col0 = u.pn * BM + wc * 32 + 8 * fq;
#pragma unroll
        for (int ai = 0; ai < 2; ++ai)
#pragma unroll
            for (int m = 0; m < 4; ++m) { const size_t ro = (size_t)(row0 + ai * HALF + m * 16) * D + col0;
#pragma unroll
                for (int bj = 0; bj < 2; ++bj) { const pg8::u32x4 gw = *(const pg8::u32x4*)(GT + ro + bj * HALF);
                    const f32x4 x0 = *(const f32x4*)(X + ro + bj * HALF), x1 = *(const f32x4*)(X + ro + bj * HALF + 4);
                    f32x4 v0 = acc[ai][bj][m][0], v1 = acc[ai][bj][m][1];
                    v0[0] = x0[0] + v0[0] * bf_lo(gw.x); v0[1] = x0[1] + v0[1] * bf_hi(gw.x); v0[2] = x0[2] + v0[2] * bf_lo(gw.y); v0[3] = x0[3] + v0[3] * bf_hi(gw.y);
                    v1[0] = x1[0] + v1[0] * bf_lo(gw.z); v1[1] = x1[1] + v1[1] * bf_hi(gw.z); v1[2] = x1[2] + v1[2] * bf_lo(gw.w); v1[3] = x1[3] + v1[3] * bf_hi(gw.w);
                    pg8::u32x4 w; w.x = cvt_pk_bf16(v0[0], v0[1]); w.y = cvt_pk_bf16(v0[2], v0[3]); w.z = cvt_pk_bf16(v1[0], v1[1]); w.w = cvt_pk_bf16(v1[2], v1[3]);
                    *(pg8::u32x4*)(O + ro + bj * HALF) = w; } }
    }
};
template <bool WITH_HB> struct EpiResid {
    static constexpr bool PERM = true;
    const float* R; float* H; bf16* HB; const float* gain; float* SSQ;
    __device__ __forceinline__ void operator()(const f32x4 (&acc)[2][2][4][2], const Unit& u, int wr, int wc, int fr, int fq) const {
        const int row0 = u.pm * BM + wr * 64 + fr, col0 = u.pn * BM + wc * 32 + 8 * fq;
        f32x4 gv[2][2];
        if (WITH_HB) {
#pragma unroll
            for (int bj = 0; bj < 2; ++bj)
#pragma unroll
                for (int n = 0; n < 2; ++n) gv[bj][n] = *(const f32x4*)(gain + col0 + bj * HALF + 4 * n);
        }
#pragma unroll
        for (int ai = 0; ai < 2; ++ai)
#pragma unroll
            for (int m = 0; m < 4; ++m) { const int row = row0 + ai * HALF + m * 16; const size_t ro = (size_t)row * D + col0; float ss = 0.f;
#pragma unroll
                for (int bj = 0; bj < 2; ++bj) {
                    const f32x4 h0 = *(const f32x4*)(R + ro + bj * HALF) + acc[ai][bj][m][0], h1 = *(const f32x4*)(R + ro + bj * HALF + 4) + acc[ai][bj][m][1];
                    ss += (h0[0] * h0[0] + h0[1] * h0[1]) + (h0[2] * h0[2] + h0[3] * h0[3]) + (h1[0] * h1[0] + h1[1] * h1[1]) + (h1[2] * h1[2] + h1[3] * h1[3]);
                    *(f32x4*)(H + ro + bj * HALF) = h0; *(f32x4*)(H + ro + bj * HALF + 4) = h1;
                    if (WITH_HB) { const f32x4 a0 = h0 * gv[bj][0], a1 = h1 * gv[bj][1];
                        pg8::u32x4 w; w.x = cvt_pk_bf16(a0[0], a0[1]); w.y = cvt_pk_bf16(a0[2], a0[3]); w.z = cvt_pk_bf16(a1[0], a1[1]); w.w = cvt_pk_bf16(a1[2], a1[3]);
                        *(pg8::u32x4*)(HB + ro + bj * HALF) = w; }
                }
                ss += __shfl_xor(ss, 16); ss += __shfl_xor(ss, 32);
                if (fq == 0) SSQ[(size_t)(u.pn * 4 + wc) * T + row] = ss;
            }
    }
};
struct EpiNull {
    static constexpr bool PERM = true;
    __device__ __forceinline__ void operator()(const f32x4 (&acc)[2][2][4][2], const Unit&, int, int, int, int) const {
#pragma unroll
        for (int ai = 0; ai < 2; ++ai)
#pragma unroll
            for (int bj = 0; bj < 2; ++bj)
#pragma unroll
                for (int m = 0; m < 4; ++m)
#pragma unroll
                    for (int n = 0; n < 2; ++n) asm volatile("" :: "v"(acc[ai][bj][m][n]));
    }
};
struct EpiSwiGLU {
    static constexpr bool PERM = true;
    bf16* O; const LAS float* RS; int pm_lo;
    __device__ __forceinline__ void operator()(const f32x4 (&acc)[2][2][4][2], const Unit& u, int wr, int wc, int fr, int fq) const {
        const int row0 = u.pm * BM + wr * 64 + fr, col0 = u.pn * HALF + wc * 32 + 8 * fq;
#pragma unroll
        for (int ai = 0; ai < 2; ++ai)
#pragma unroll
            for (int m = 0; m < 4; ++m) { const int row = row0 + ai * HALF + m * 16; const float r = RS[row - pm_lo * BM];
                float o[8];
#pragma unroll
                for (int n = 0; n < 2; ++n)
#pragma unroll
                    for (int j = 0; j < 4; ++j) { const float gt = acc[ai][0][m][n][j] * r, up = acc[ai][1][m][n][j] * r; o[4 * n + j] = fsilu(gt) * up; }
                pg8::u32x4 w; w.x = cvt_pk_bf16(o[0], o[1]); w.y = cvt_pk_bf16(o[2], o[3]); w.z = cvt_pk_bf16(o[4], o[5]); w.w = cvt_pk_bf16(o[6], o[7]);
                *(pg8::u32x4*)(O + (size_t)row * DFF + col0) = w; }
    }
};

struct Frame {
    LAS unsigned char* lds;
    volatile LAS unsigned* MISC;
    gu32* ctl;
    int tid, lane, wave;
    int vcu, G;
};
__device__ __forceinline__ float wave_sum(float v) {
#pragma unroll
    for (int o = 1; o < 64; o <<= 1) v += __shfl_xor(v, o);
    return v;
}
__device__ __forceinline__ void p0_transpose_item(const float* W, int N, bf16* WT, int ldt, int rowmode, LAS float* scr, int kb, int nb, int lane) {
    const int k0 = 64 * kb, n0 = 32 * nb;
    const int lk = lane >> 3, ln = (lane & 7) * 4;
#pragma unroll
    for (int i = 0; i < 8; ++i) { const int kk = 8 * i + lk; const f32x4 v = *(const GAS f32x4*)(W + (size_t)(k0 + kk) * N + n0 + ln);
        scr[kk * 33 + ln] = v[0]; scr[kk * 33 + ln + 1] = v[1]; scr[kk * 33 + ln + 2] = v[2]; scr[kk * 33 + ln + 3] = v[3]; }
    LDS_WAIT(); asm volatile("" ::: "memory");
    const int c = lane & 7;
#pragma unroll
    for (int j = 0; j < 4; ++j) { const int n = (lane >> 3) + 8 * j; const LAS float* s = scr + (8 * c) * 33 + n;
        v4u o; o.x = pk2(s[0 * 33], s[1 * 33]); o.y = pk2(s[2 * 33], s[3 * 33]); o.z = pk2(s[4 * 33], s[5 * 33]); o.w = pk2(s[6 * 33], s[7 * 33]);
        const int ng = n0 + n; const int row = rowmode == 0 ? ng : ((ng >> 7) * 256 + (rowmode == 2 ? 128 : 0) + (ng & 127));
        *(GAS v4u*)(WT + (size_t)row * ldt + k0 + 8 * c) = o; }
    LDS_WAIT(); asm volatile("" ::: "memory");
}
__device__ __forceinline__ void p0_transpose_matrix(const float* W, int K, int N, bf16* WT, int ldt, int rowmode, LAS float* scr, int gw, int NGW, int lane) {
    const int nblk = N / 32, nitems = (K / 64) * nblk;
    for (int it = gw; it < nitems; it += NGW) p0_transpose_item(W, N, WT, ldt, rowmode, scr, it / nblk, it % nblk, lane);
}

template <int W>
__device__ __forceinline__ void pool_item(const bf16* Z, bf16* P, int t4, int c8) {
    v4u rows[W + 3];
#pragma unroll
    for (int i = 0; i < W + 3; ++i) { const int t = t4 - (W - 1) + i; rows[i] = (t >= 0) ? *(const GAS v4u*)(Z + (size_t)t * PW + c8) : (v4u){0u, 0u, 0u, 0u}; }
    float s[8];
#pragma unroll
    for (int j = 0; j < 8; ++j) s[j] = 0.f;
#pragma unroll
    for (int i = 0; i < W - 1; ++i) { const v4u q = rows[i];
        s[0] += pg8::bf_lo(q.x); s[1] += pg8::bf_hi(q.x); s[2] += pg8::bf_lo(q.y); s[3] += pg8::bf_hi(q.y); s[4] += pg8::bf_lo(q.z); s[5] += pg8::bf_hi(q.z); s[6] += pg8::bf_lo(q.w); s[7] += pg8::bf_hi(q.w); }
#pragma unroll
    for (int r = 0; r < 4; ++r) {
        const v4u q = rows[W - 1 + r]; const float z[8] = {pg8::bf_lo(q.x), pg8::bf_hi(q.x), pg8::bf_lo(q.y), pg8::bf_hi(q.y), pg8::bf_lo(q.z), pg8::bf_hi(q.z), pg8::bf_lo(q.w), pg8::bf_hi(q.w)};
#pragma unroll
        for (int j = 0; j < 8; ++j) s[j] += z[j];
        const int t = t4 + r; const float inv = 1.0f / (float)(t + 1 < W ? t + 1 : W);
        v4u o; o.x = pk2(s[0] * inv - z[0], s[1] * inv - z[1]); o.y = pk2(s[2] * inv - z[2], s[3] * inv - z[3]); o.z = pk2(s[4] * inv - z[4], s[5] * inv - z[5]); o.w = pk2(s[6] * inv - z[6], s[7] * inv - z[7]);
        *(GAS v4u*)(P + (size_t)t * PW + c8) = o;
        const v4u d = rows[r];
        s[0] -= pg8::bf_lo(d.x); s[1] -= pg8::bf_hi(d.x); s[2] -= pg8::bf_lo(d.y); s[3] -= pg8::bf_hi(d.y); s[4] -= pg8::bf_lo(d.z); s[5] -= pg8::bf_hi(d.z); s[6] -= pg8::bf_lo(d.w); s[7] -= pg8::bf_hi(d.w);
    }
}

constexpr int HG_QA = 0, HG_KA = HG_QA + 8704, HG_KDT = HG_KA + 8704, HG_VT = HG_KDT + 10240, HG_ST = HG_VT + 10240, HG_P = HG_ST + 34816, HG_OCT = HG_P + 2560, HG_DEC = HG_OCT + 2048, HG_SSQ = HG_DEC + 512,
              HG_RAW = HG_SSQ + 1024  , HG_YT = HG_RAW + 5 * 8192, HG_END = HG_YT + 8192;
static_assert(HG_END <= RING_BYTES, "HGRN LDS map");
typedef short bf16x8_t __attribute__((ext_vector_type(8)));
__device__ __forceinline__ float dpp_xor_sum16(float x) {
    int v = __builtin_bit_cast(int, x);
    x += __builtin_bit_cast(float, __builtin_amdgcn_update_dpp(0, v, 0xB1, 0xF, 0xF, true)); v = __builtin_bit_cast(int, x);
    x += __builtin_bit_cast(float, __builtin_amdgcn_update_dpp(0, v, 0x4E, 0xF, 0xF, true)); v = __builtin_bit_cast(int, x);
    x += __builtin_bit_cast(float, __builtin_amdgcn_update_dpp(0, v, 0x141, 0xF, 0xF, true)); v = __builtin_bit_cast(int, x);
    x += __builtin_bit_cast(float, __builtin_amdgcn_update_dpp(0, v, 0x140, 0xF, 0xF, true));
    return x;
}
template <bool FULL, int VAR = 0>
__device__ __forceinline__ void hgrn_pass(LAS unsigned char* lds, int h, int sc, const bf16* QS, const bf16* Gl, const bf16* KK, const bf16* Vv, const bf16* OG, const float* hnorm,
                                          float* Ubuf, float* Dtot, const float* Sin, bf16* YH, int tid, int lane, int w) {
    const int k = tid & 127, ro = tid >> 7, fr = lane & 15, q = lane >> 4;
    const int lt = tid >> 4, lc = tid & 15;
    LAS bf16* QA = (LAS bf16*)(lds + HG_QA); LAS bf16* KA = (LAS bf16*)(lds + HG_KA); LAS bf16* KDT = (LAS bf16*)(lds + HG_KDT); LAS bf16* VT = (LAS bf16*)(lds + HG_VT);
    LAS bf16* ST = (LAS bf16*)(lds + HG_ST); LAS bf16* Pm = (LAS bf16*)(lds + HG_P); LAS float* OCT = (LAS float*)(lds + HG_OCT); LAS float* DEC = (LAS float*)(lds + HG_DEC); LAS float* SSQ = (LAS float*)(lds + HG_SSQ);
    LAS bf16* RG = (LAS bf16*)(lds + HG_RAW); LAS bf16* RK = RG + 4096; LAS bf16* RV = RG + 8192; LAS bf16* RQ = RG + 12288; LAS bf16* RO = RG + 16384; LAS bf16* YT = (LAS bf16*)(lds + HG_YT);
    const size_t item = (size_t)(h * 16 + sc);
    f32x4 S[8];
#pragma unroll
    for (int kb = 0; kb < 8; ++kb) {
        if (FULL) {
#pragma unroll
            for (int r = 0; r < 4; ++r) S[kb][r] = Sin[(item << 14) + (size_t)(16 * kb + 4 * q + r) * 128 + 16 * w + fr];
        } else S[kb] = (f32x4){0.f, 0.f, 0.f, 0.f};
    }
    if (FULL) { for (int i = tid; i < 32 * 40; i += 512) Pm[i] = 0; }
    const size_t cb = (size_t)h * HD;
    const int t00 = sc * 512;
    const float hn = FULL ? hnorm[h * HD + 16 * w + fr] : 0.f;
    float btot = 0.f;
    const size_t goff = (size_t)(t00 + lt) * HW + cb + 8 * lc;
    v4u rg = *(const GAS v4u*)(Gl + goff), rk = *(const GAS v4u*)(KK + goff), rv = *(const GAS v4u*)(Vv + goff), rq = (v4u){0u, 0u, 0u, 0u}, rog = (v4u){0u, 0u, 0u, 0u};
    if (FULL) { rq = *(const GAS v4u*)(QS + goff); rog = *(const GAS v4u*)(OG + goff); }
    *(LAS v4u*)(RG + tid * 8) = rg; *(LAS v4u*)(RK + tid * 8) = rk; *(LAS v4u*)(RV + tid * 8) = rv; if (FULL) { *(LAS v4u*)(RQ + tid * 8) = rq; *(LAS v4u*)(RO + tid * 8) = rog; }
    { const size_t g1 = goff + (size_t)32 * HW; rg = *(const GAS v4u*)(Gl + g1); rk = *(const GAS v4u*)(KK + g1); rv = *(const GAS v4u*)(Vv + g1); if (FULL) { rq = *(const GAS v4u*)(QS + g1); rog = *(const GAS v4u*)(OG + g1); } }
    __syncthreads();
#pragma unroll 1
    for (int blk = 0; blk < 16; ++blk) {
        const int t0 = t00 + 32 * blk;
        float c[8]; c[0] = bf2f(RG[(8 * ro) * 128 + k]);
#pragma unroll
        for (int j = 1; j < 8; ++j) c[j] = c[j - 1] + bf2f(RG[(8 * ro + j) * 128 + k]);
        OCT[ro * 128 + k] = c[7];
        __syncthreads();
        if (FULL && blk > 0 && !(VAR & 1)) *(GAS v4u*)(YH + goff + (size_t)(32 * (blk - 1)) * HW) = *(const LAS v4u*)(YT + tid * 8);
        const float o0 = OCT[k], o1 = OCT[128 + k], o2 = OCT[256 + k], o3 = OCT[384 + k];
        const float off = (ro > 0 ? o0 : 0.f) + (ro > 1 ? o1 : 0.f) + (ro > 2 ? o2 : 0.f); const float b32 = (o0 + o1) + (o2 + o3);
        btot += b32;
        { unsigned kdw[4], vw[4];
#pragma unroll
          for (int j = 0; j < 8; j += 2) {
              const float b0 = off + c[j], b1 = off + c[j + 1]; const float k0 = bf2f(RK[(8 * ro + j) * 128 + k]), k1 = bf2f(RK[(8 * ro + j + 1) * 128 + k]);
              kdw[j >> 1] = pk2(k0 * __expf(b32 - b0), k1 * __expf(b32 - b1)); vw[j >> 1] = (unsigned)RV[(8 * ro + j) * 128 + k] | ((unsigned)RV[(8 * ro + j + 1) * 128 + k] << 16);
              if (FULL && !(VAR & 8)) { const float e0 = __expf(b0), e1 = __expf(b1); const float i0 = __expf(fminf(-b0, 80.f)), i1 = __expf(fminf(-b1, 80.f));
                  QA[(8 * ro + j) * 136 + k] = (bf16)f2bf(bf2f(RQ[(8 * ro + j) * 128 + k]) * e0); QA[(8 * ro + j + 1) * 136 + k] = (bf16)f2bf(bf2f(RQ[(8 * ro + j + 1) * 128 + k]) * e1);
                  KA[(8 * ro + j) * 136 + k] = (bf16)f2bf(k0 * i0); KA[(8 * ro + j + 1) * 136 + k] = (bf16)f2bf(k1 * i1); }
          }
          *(LAS v4u*)(KDT + k * 40 + 8 * ro) = (v4u){kdw[0], kdw[1], kdw[2], kdw[3]};
          *(LAS v4u*)(VT + k * 40 + 8 * ro) = (v4u){vw[0], vw[1], vw[2], vw[3]}; }
        if (ro == 0) DEC[k] = __expf(b32);
        unsigned short og[8];
        if (FULL) {
#pragma unroll
            for (int kb = 0; kb < 8; ++kb) { v2u wv; wv.x = pk2(S[kb][0], S[kb][1]); wv.y = pk2(S[kb][2], S[kb][3]); *(LAS v2u*)(ST + (16 * w + fr) * 136 + 16 * kb + 4 * q) = wv; }
#pragma unroll
            for (int tb = 0; tb < 2; ++tb)
#pragma unroll
                for (int r = 0; r < 4; ++r) og[tb * 4 + r] = RO[(16 * tb + 4 * q + r) * 128 + 16 * w + fr];
        }
        __syncthreads();
        if (blk < 15) {
            *(LAS v4u*)(RG + tid * 8) = rg; *(LAS v4u*)(RK + tid * 8) = rk; *(LAS v4u*)(RV + tid * 8) = rv; if (FULL) { *(LAS v4u*)(RQ + tid * 8) = rq; *(LAS v4u*)(RO + tid * 8) = rog; }
            if (blk < 14) { const size_t g2 = goff + (size_t)(32 * (blk + 2)) * HW; rg = *(const GAS v4u*)(Gl + g2); rk = *(const GAS v4u*)(KK + g2); rv = *(const GAS v4u*)(Vv + g2); if (FULL) { rq = *(const GAS v4u*)(QS + g2); rog = *(const GAS v4u*)(OG + g2); } }
        }
        f32x4 oacc[2] = {(f32x4){0.f, 0.f, 0.f, 0.f}, (f32x4){0.f, 0.f, 0.f, 0.f}};
        const bf16x8_t bV = *(const LAS bf16x8_t*)(VT + (16 * w + fr) * 40 + 8 * q);
        if (FULL) {
            if (w < 3 && !(VAR & 2)) {
                const int tb = w > 0 ? 1 : 0, sb = w > 1 ? 1 : 0; f32x4 pa = (f32x4){0.f, 0.f, 0.f, 0.f};
#pragma unroll
                for (int kk = 0; kk < 4; ++kk) { const bf16x8_t a = *(const LAS bf16x8_t*)(QA + (16 * tb + fr) * 136 + 32 * kk + 8 * q); const bf16x8_t b = *(const LAS bf16x8_t*)(KA + (16 * sb + fr) * 136 + 32 * kk + 8 * q);
                    pa = __builtin_amdgcn_mfma_f32_16x16x32_bf16(a, b, pa, 0, 0, 0); }
#pragma unroll
                for (int r = 0; r < 4; ++r) { const int t = 16 * tb + 4 * q + r, s_ = 16 * sb + fr; Pm[t * 40 + s_] = (bf16)f2bf(s_ <= t ? pa[r] : 0.f); }
            }
            if (!(VAR & 4))
#pragma unroll
            for (int tb = 0; tb < 2; ++tb)
#pragma unroll
                for (int kk = 0; kk < 4; ++kk) { const bf16x8_t a = *(const LAS bf16x8_t*)(QA + (16 * tb + fr) * 136 + 32 * kk + 8 * q); const bf16x8_t b = *(const LAS bf16x8_t*)(ST + (16 * w + fr) * 136 + 32 * kk + 8 * q);
                    oacc[tb] = __builtin_amdgcn_mfma_f32_16x16x32_bf16(a, b, oacc[tb], 0, 0, 0); }
        }
#pragma unroll
        for (int kb = 0; kb < 8; ++kb) { const f32x4 d4 = *(const LAS f32x4*)(DEC + 16 * kb + 4 * q); const bf16x8_t a = *(const LAS bf16x8_t*)(KDT + (16 * kb + fr) * 40 + 8 * q);
            S[kb] = __builtin_amdgcn_mfma_f32_16x16x32_bf16(a, bV, S[kb] * d4, 0, 0, 0); }
        __syncthreads();
        if (FULL) {
#pragma unroll
            for (int tb = 0; tb < 2; ++tb) { const bf16x8_t a = *(const LAS bf16x8_t*)(Pm + (16 * tb + fr) * 40 + 8 * q); oacc[tb] = __builtin_amdgcn_mfma_f32_16x16x32_bf16(a, bV, oacc[tb], 0, 0, 0); }
            if (VAR & 1) { asm volatile("" :: "v"(oacc[0]), "v"(oacc[1])); } else {
            float ssv[8];
#pragma unroll
            for (int tb = 0; tb < 2; ++tb)
#pragma unroll
                for (int r = 0; r < 4; ++r) ssv[tb * 4 + r] = dpp_xor_sum16(oacc[tb][r] * oacc[tb][r]);
            if (fr == 0) {
#pragma unroll
                for (int tb = 0; tb < 2; ++tb)
#pragma unroll
                    for (int r = 0; r < 4; ++r) SSQ[(16 * tb + 4 * q + r) * 8 + w] = ssv[tb * 4 + r]; }
            __syncthreads();
#pragma unroll
            for (int tb = 0; tb < 2; ++tb)
#pragma unroll
                for (int r = 0; r < 4; ++r) { const int t = 16 * tb + 4 * q + r; const f32x4 p0 = *(const LAS f32x4*)(SSQ + t * 8), p1 = *(const LAS f32x4*)(SSQ + t * 8 + 4);
                    const float tot = ((p0[0] + p0[1]) + (p0[2] + p0[3])) + ((p1[0] + p1[1]) + (p1[2] + p1[3])); const float rinv = __builtin_amdgcn_rsqf(tot * (1.0f / HD) + EPS);
                    YT[t * 128 + 16 * w + fr] = (bf16)f2bf(oacc[tb][r] * rinv * hn * bf2f(og[tb * 4 + r])); }
            }
        }
    }
    if (FULL && !(VAR & 1)) { __syncthreads(); *(GAS v4u*)(YH + goff + (size_t)(32 * 15) * HW) = *(const LAS v4u*)(YT + tid * 8); }
    if (!FULL) {
#pragma unroll
        for (int kb = 0; kb < 8; ++kb)
#pragma unroll
            for (int r = 0; r < 4; ++r) Ubuf[(item << 14) + (size_t)(16 * kb + 4 * q + r) * 128 + 16 * w + fr] = S[kb][r];
        if (ro == 0) Dtot[item * 128 + k] = __expf(btot);
    }
    __syncthreads();
}

struct Args { const float* in[15]; float* out; unsigned char* ws; int ph_lo, ph_hi, li, pad; };

__global__ void __launch_bounds__(NWAVES * 64, 2) fwd(Args args) {
    extern __shared__ __attribute__((aligned(16))) unsigned char lds[];
    Frame F;
    F.lds = (LAS unsigned char*)lds;
    F.MISC = (volatile LAS unsigned*)(F.lds + MISC_OFF);
    F.tid = threadIdx.x; F.lane = F.tid & 63; F.wave = __builtin_amdgcn_readfirstlane(F.tid >> 6);
    F.G = gridDim.x; { const int bx = blockIdx.x; F.vcu = (F.G % 8 == 0) ? (bx % 8) * (F.G / 8) + bx / 8 : bx; }
    unsigned char* ws = args.ws;
    F.ctl = (gu32*)(ws + WS_CTL);
    const float* x = args.in[0]; const float* g_mix = args.in[1]; const float* w_in = args.in[2]; const float* w_pg = args.in[3]; const float* pool_scale = args.in[4];
    const float* lb_param = args.in[5]; const float* hgrn_norm = args.in[6]; const float* w_up_pool = args.in[7]; const float* w_up_hgrn = args.in[8]; const float* w_out = args.in[9];
    const float* g_ffn = args.in[10]; const float* w_gate = args.in[11]; const float* w_up = args.in[12]; const float* w_down = args.in[13]; const float* g_final = args.in[14];
    float* out = args.out;
    bf16* WinT = (bf16*)(ws + WS_WIN); bf16* WpgT = (bf16*)(ws + WS_WPG); bf16* WupT = (bf16*)(ws + WS_WUP); bf16* WuhT = (bf16*)(ws + WS_WUH); bf16* WoT = (bf16*)(ws + WS_WO);
    bf16* WguT = (bf16*)(ws + WS_WGU); bf16* WdT = (bf16*)(ws + WS_WD);
    bf16* U = (bf16*)(ws + WS_U); bf16* MG = U;
    bf16* Zb = (bf16*)(ws + WS_Z); bf16* QSb = (bf16*)(ws + WS_QS); bf16* Gb = (bf16*)(ws + WS_G); bf16* KKb = (bf16*)(ws + WS_KK); bf16* Vb = (bf16*)(ws + WS_V); bf16* OGb = (bf16*)(ws + WS_OG);
    bf16* GAb = (bf16*)(ws + WS_GA); bf16* GBb = (bf16*)(ws + WS_GB); bf16* ACT = (bf16*)(ws + WS_ACT);
    bf16* Pb = (bf16*)(ws + WS_P); bf16* YP = (bf16*)(ws + WS_YP); bf16* YH = (bf16*)(ws + WS_YH); bf16* H1B = (bf16*)(ws + WS_H1B);
    float* HU = (float*)(ws + WS_HU); float* HS = (float*)(ws + WS_HS); float* HDt = (float*)(ws + WS_HD); float* SSQ1 = (float*)(ws + WS_SSQ1); float* SSQ2 = (float*)(ws + WS_SSQ2); float* RS1 = (float*)(ws + WS_RS1);

    for (int u = F.tid; u < (LDS_BYTES - LDSCTL_OFF) / 4; u += NWAVES * 64) ((LAS unsigned*)(F.lds + LDSCTL_OFF))[u] = 0u;
    __syncthreads();
    XcdBarrier bar; bar.bar = (unsigned*)(F.ctl + 4096); bar.x = 0; bar.st = nullptr;
    if (N_LAUNCHES == 1) bar = xcd_barrier_post((unsigned*)(F.ctl + 4096), F.MISC + 8);
#define GRID_BAR() do { if (N_LAUNCHES == 1) xcd_barrier(bar); } while (0)
    const int lo = args.ph_lo, hi = args.ph_hi;
#define IN(k) (lo <= (k) && (k) < hi)
#define BOTH(k) (IN(k) && IN((k) + 1))
    const int gw = F.vcu * NWAVES + F.wave, NGW = F.G * NWAVES;
    const int gt = F.vcu * (NWAVES * 64) + F.tid, NGT = F.G * NWAVES * 64;

    if (IN(0)) {
        LAS float* scr = (LAS float*)(F.lds + RING_OFF + F.wave * 16384);
        p0_transpose_matrix(w_in, D, NIN, WinT, D, 0, scr, gw, NGW, F.lane);
#pragma unroll 1
        for (int gi = 0; gi < 4; ++gi) p0_transpose_matrix(w_pg + (size_t)gi * 512 * 512, 512, 512, WpgT + (size_t)gi * 512 * 512, 512, 0, scr, gw, NGW, F.lane);
        p0_transpose_matrix(w_up_pool, PW, D, WupT, PW, 0, scr, gw, NGW, F.lane);
        p0_transpose_matrix(w_up_hgrn, HW, D, WuhT, HW, 0, scr, gw, NGW, F.lane);
        p0_transpose_matrix(w_out, D, D, WoT, D, 0, scr, gw, NGW, F.lane);
        p0_transpose_matrix(w_gate, D, DFF, WguT, D, 1, scr, gw, NGW, F.lane);
        p0_transpose_matrix(w_up, D, DFF, WguT, D, 2, scr, gw, NGW, F.lane);
        p0_transpose_matrix(w_down, DFF, D, WdT, DFF, 0, scr, gw, NGW, F.lane);
        for (int m = gw; m < T; m += NGW) {
            const GAS f32x4* xr = (const GAS f32x4*)(x + (size_t)m * D) + F.lane; const GAS f32x4* gr = (const GAS f32x4*)g_mix + F.lane;
            f32x4 v[16]; float s = 0.f;
#pragma unroll
            for (int j = 0; j < 16; ++j) { v[j] = xr[64 * j]; s += (v[j][0] * v[j][0] + v[j][1] * v[j][1]) + (v[j][2] * v[j][2] + v[j][3] * v[j][3]); }
            const float r = 1.0f / sqrtf(wave_sum(s) * (1.0f / D) + EPS);
            GAS v2u* o8 = (GAS v2u*)(U + (size_t)m * D) + F.lane;
#pragma unroll
            for (int j = 0; j < 16; ++j) { const f32x4 gg = gr[64 * j]; v2u w; w.x = pk2(v[j][0] * r * gg[0], v[j][1] * r * gg[1]); w.y = pk2(v[j][2] * r * gg[2], v[j][3] * r * gg[3]); o8[64 * j] = w; }
        }
        if (BOTH(0)) GRID_BAR();
    }
    if (IN(1)) {
        pg8::Gemm g{U, WinT, T, NIN, D, D, D, 0, 0}; pg8::StaticOrder S; S.init(T, NIN, F.G, (int)blockIdx.x);
        EpiProj E{Zb, lb_param};
        pg8::gemm_phase<EpiProj, pg8::StaticOrder, true, true>(F.lds + RING_OFF, g, S, E);
        if (BOTH(1)) GRID_BAR();
    }
    if (IN(2)) {
        for (int it = gw; it < (T / 4) * 4; it += NGW) {
            const int t4 = (it >> 2) * 4, gi = it & 3, c8 = gi * 512 + F.lane * 8;
            if (gi == 0) pool_item<2>(Zb, Pb, t4, c8); else if (gi == 1) pool_item<4>(Zb, Pb, t4, c8); else if (gi == 2) pool_item<8>(Zb, Pb, t4, c8); else pool_item<16>(Zb, Pb, t4, c8);
        }
        for (int b = F.vcu; b < NH * 16; b += F.G)
            hgrn_pass<false>(F.lds + RING_OFF, b >> 4, b & 15, QSb, Gb, KKb, Vb, OGb, hgrn_norm, HU, HDt, HS, YH, F.tid, F.lane, F.wave);
        if (BOTH(2)) GRID_BAR();
    }
    if (IN(3)) {
        pg8::Gemm g{Pb, WpgT, T, PW, 512, PW, 512, 1, 512}; pg8::StaticOrder S; S.init(T, PW, F.G, (int)blockIdx.x);
        EpiScaleBf16 E{YP, PW, pool_scale};
        pg8::gemm_phase<EpiScaleBf16, pg8::StaticOrder, true, true>(F.lds + RING_OFF, g, S, E);
        for (int e = gt; e < NH * HD * HD; e += NGT) {
            const int h = e >> 14, kv = e & 16383, k = kv >> 7; float Sc = 0.f;
#pragma unroll
            for (int sc = 0; sc < 16; ++sc) { const size_t it = (size_t)(h * 16 + sc); HS[(it << 14) + kv] = Sc; Sc = HDt[it * 128 + k] * Sc + HU[(it << 14) + kv]; }
        }
        if (BOTH(3)) GRID_BAR();
    }
    if (IN(4)) {
        for (int b = F.vcu; b < NH * 16; b += F.G)
            hgrn_pass<true>(F.lds + RING_OFF, b >> 4, b & 15, QSb, Gb, KKb, Vb, OGb, hgrn_norm, HU, HDt, HS, YH, F.tid, F.lane, F.wave);
        { pg8::Gemm g{YP, WupT, T, D, PW, PW, PW, 0, 0}; pg8::StaticOrder S; S.init(T, D, F.G, (int)blockIdx.x);
          EpiGateF32 E{out, GAb};
          pg8::gemm_phase<EpiGateF32, pg8::StaticOrder, true, true>(F.lds + RING_OFF, g, S, E); }
        if (BOTH(4)) GRID_BAR();
    }
    if (IN(5)) {
        { pg8::Gemm g{YH, WuhT, T, D, HW, HW, HW, 0, 0}; pg8::StaticOrder S; S.init(T, D, F.G, (int)blockIdx.x);
          EpiGateAddBf16 E{out, GBb, MG};
          pg8::gemm_phase<EpiGateAddBf16, pg8::StaticOrder, true, true>(F.lds + RING_OFF, g, S, E); }
        if (BOTH(5)) GRID_BAR();
    }
    if (IN(6)) {
        pg8::Gemm g{MG, WoT, T, D, D, D, D, 0, 0}; pg8::StaticOrder S; S.init(T, D, F.G, (int)blockIdx.x);
        EpiResid<true> E{x, out, H1B, g_ffn, SSQ1};
        pg8::gemm_phase<EpiResid<true>, pg8::StaticOrder, true, true>(F.lds + RING_OFF, g, S, E);
        if (BOTH(6)) GRID_BAR();
    }
    if (IN(7)) {
    }
    if (IN(8)) {
        pg8::Gemm g{H1B, WguT, T, 2 * DFF, D, D, D, 0, 0}; pg8::StaticOrder S; S.init(T, 2 * DFF, F.G, (int)blockIdx.x);
        LAS float* rsl = (LAS float*)(F.lds + RS_OFF);
        { pg8::Unit u0; int pm_lo = 1 << 30, pm_hi = -1;
          for (int i = 0; S.next(i, u0); ++i) { pm_lo = u0.pm < pm_lo ? u0.pm : pm_lo; pm_hi = u0.pm > pm_hi ? u0.pm : pm_hi; }
          for (int pmx = pm_lo; pmx <= pm_hi && pmx < pm_lo + RS_PANELS; ++pmx)
              for (int r = F.tid; r < 256; r += NWAVES * 64) { float sq = 0.f;
#pragma unroll 8
                  for (int p = 0; p < 64; ++p) sq += SSQ1[(size_t)p * T + pmx * 256 + r];
                  rsl[(pmx - pm_lo) * 256 + r] = 1.0f / sqrtf(sq * (1.0f / D) + EPS); }
          __syncthreads();
          EpiSwiGLU E{ACT, rsl, pm_lo};
          pg8::gemm_phase<EpiSwiGLU, pg8::StaticOrder, true, true>(F.lds + RING_OFF, g, S, E); }
        if (BOTH(8)) GRID_BAR();
    }
    if (IN(9)) {
        pg8::Gemm g{ACT, WdT, T, D, DFF, DFF, DFF, 0, 0}; pg8::StaticOrder S; S.init(T, D, F.G, (int)blockIdx.x);
        EpiResid<false> E{out, out, nullptr, nullptr, SSQ2};
        pg8::gemm_phase<EpiResid<false>, pg8::StaticOrder, true, true>(F.lds + RING_OFF, g, S, E);
        if (BOTH(9)) GRID_BAR();
    }
    if (IN(10)) {
        for (int m = gw; m < T; m += NGW) {
            const float r = 1.0f / sqrtf(wave_sum(SSQ2[(size_t)F.lane * T + m]) * (1.0f / D) + EPS);
            GAS f32x4* orow = (GAS f32x4*)(out + (size_t)m * D) + F.lane; const GAS f32x4* gr = (const GAS f32x4*)g_final + F.lane;
#pragma unroll
            for (int j = 0; j < 16; ++j) { const f32x4 v = orow[64 * j]; const f32x4 gg = gr[64 * j]; orow[64 * j] = v * r * gg; }
        }
    }
#if PROBE_DUP >= 11
    if (IN(11)) {
        pg8::Gemm g{U, WinT, T, NIN, D, D, D, 0, 0}; pg8::StaticOrder S; S.init(T, NIN, F.G, (int)blockIdx.x);
        EpiNull E{};
        pg8::gemm_phase<EpiNull, pg8::StaticOrder, true, true>(F.lds + RING_OFF, g, S, E);
    }
    if (IN(12)) {
        pg8::Gemm g{ACT, WdT, T, D, DFF, DFF, DFF, 0, 0}; pg8::StaticOrder S; S.init(T, D, F.G, (int)blockIdx.x);
        EpiNull E{};
        pg8::gemm_phase<EpiNull, pg8::StaticOrder, true, true>(F.lds + RING_OFF, g, S, E);
    }
    if (IN(14)) { for (int b = F.vcu; b < NH * 16; b += F.G) hgrn_pass<true>(F.lds + RING_OFF, b >> 4, b & 15, QSb, Gb, KKb, Vb, OGb, hgrn_norm, HU, HDt, HS, YH, F.tid, F.lane, F.wave); }
    if (IN(15)) { for (int b = F.vcu; b < NH * 16; b += F.G) hgrn_pass<false>(F.lds + RING_OFF, b >> 4, b & 15, QSb, Gb, KKb, Vb, OGb, hgrn_norm, HU, HDt, HS, YH, F.tid, F.lane, F.wave); }
    if (IN(16)) { for (int it = gw; it < (T / 4) * 4; it += NGW) { const int t4 = (it >> 2) * 4, gi = it & 3, c8 = gi * 512 + F.lane * 8;
            if (gi == 0) pool_item<2>(Zb, Pb, t4, c8); else if (gi == 1) pool_item<4>(Zb, Pb, t4, c8); else if (gi == 2) pool_item<8>(Zb, Pb, t4, c8); else pool_item<16>(Zb, Pb, t4, c8); } }
#endif
#undef IN
#undef BOTH
#undef GRID_BAR
}

extern "C" void kernel_launch(void* const* d_in, const int* in_sizes, int n_in, void* d_out, int out_size, void* d_ws, size_t ws_size, hipStream_t stream) {
    static int grid = 0;
    if (grid == 0) {
        if (n_in != 15 || in_sizes[0] != T * D || out_size != T * D || ws_size < WS_END) { fprintf(stderr, "kernel_launch: unexpected shapes: n_in %d in0 %d out %d ws %zu (need %zu)\n", n_in, n_in > 0 ? in_sizes[0] : -1, out_size, ws_size, (size_t)WS_END); grid = -1; return; }
        int dev = 0, cus = 0, per_cu = 0;
        if (hipGetDevice(&dev) != hipSuccess || hipDeviceGetAttribute(&cus, hipDeviceAttributeMultiprocessorCount, dev) != hipSuccess) { grid = -1; return; }
        if (hipFuncSetAttribute((const void*)fwd, hipFuncAttributeMaxDynamicSharedMemorySize, LDS_BYTES) != hipSuccess) { fprintf(stderr, "kernel_launch: hipFuncSetAttribute failed\n"); grid = -1; return; }
        if (hipOccupancyMaxActiveBlocksPerMultiprocessor(&per_cu, (const void*)fwd, NWAVES * 64, LDS_BYTES) != hipSuccess || per_cu < 1) fprintf(stderr, "kernel_launch: occupancy query says %d\n", per_cu);
        (void)hipGetLastError();
        grid = cus;
    }
    if (grid < 0) return;
    if (hipMemsetAsync((char*)d_ws + WS_CTL, 0, CTL_ZERO_BYTES, stream) != hipSuccess) return;
    Args a{};
    for (int i = 0; i < 15; ++i) a.in[i] = (const float*)d_in[i];
    a.out = (float*)d_out; a.ws = (unsigned char*)d_ws;
    for (int li = 0; li < N_LAUNCHES; ++li) {
        a.ph_lo = (N_LAUNCHES == NPHASE) ? li : 0; a.ph_hi = (N_LAUNCHES == NPHASE) ? li + 1 : NPHASE; a.li = li;
        hipLaunchKernelGGL(fwd, dim3(grid), dim3(NWAVES * 64), LDS_BYTES, stream, a);
        const hipError_t le = hipPeekAtLastError();
        if (le != hipSuccess) { fprintf(stderr, "kernel_launch: launch %d failed: %s\n", li, hipGetErrorName(le)); break; }
    }
    if (N_LAUNCHES == NPHASE && PROBE_DUP >= 0) {
        a.ph_lo = PROBE_DUP; a.ph_hi = PROBE_DUP + 1; a.li = 0;
        for (int rep = 0; rep < PROBE_REPS; ++rep) hipLaunchKernelGGL(fwd, dim3(grid), dim3(NWAVES * 64), LDS_BYTES, stream, a);
    }
}
```

```cpp
#include <hip/hip_runtime.h>
#include <cstdio>
#include <cstdint>

#ifndef PROBE_DUP
#define PROBE_DUP -1
#endif
#ifndef PROBE_REPS
#define PROBE_REPS 1
#endif
#ifndef MK_N_LAUNCHES
#define MK_N_LAUNCHES 1
#endif

namespace pg8 {
#define PG8_LAS __attribute__((address_space(3)))
typedef unsigned short bf16_t;
typedef short bf16x8 __attribute__((ext_vector_type(8)));
typedef float f32x4 __attribute__((ext_vector_type(4)));
typedef unsigned u32x4 __attribute__((ext_vector_type(4)));
typedef unsigned u32x2 __attribute__((ext_vector_type(2)));
constexpr int BM = 256, BK = 64, HALF = 128, HTB = HALF * BK * 2  , STAGE_BYTES = 8 * HTB, NXCD = 8, WGM = 8;

__host__ __device__ __forceinline__ int lds_byte(int r, int c) { const int st = (r >> 4) * 2 + (c >> 5), rr = r & 15, cc = c & 31, ob = rr * 64 + cc * 2; return st * 1024 + (ob ^ (((ob >> 9) & 1) << 5)); }
__host__ __device__ __forceinline__ void stage_rc(int b, int& R, int& C) { const int st = b / 1024, sb = b % 1024, swz = sb ^ (((sb >> 9) & 1) << 5); R = (st >> 1) * 16 + swz / 64; C = (st & 1) * 32 + (swz % 64) / 2; }
__host__ __device__ __forceinline__ int perm32(int rho) { const int n = rho >> 4, i = rho & 15; return 8 * (i >> 2) + 4 * n + (i & 3); }

struct Unit { int pm, pn; };
struct Gemm { const bf16_t* A; const bf16_t* Bt; int M, N, K, lda, ldb, agrp_shift, agrp_stride; };

struct StaticOrder {
    int nM, nN, nwg, G, c;
    __host__ __device__ void init(int M, int N, int G_, int c_) { nM = M / BM; nN = N / BM; nwg = nM * nN; G = G_; c = c_; }
    __host__ __device__ bool next(int i, Unit& u) const {
        const long L = (long)i * G + c; if (L >= nwg) return false;
        int wgid = (int)L; { const int q = nwg / NXCD, r = nwg % NXCD, xcd = wgid % NXCD, off = wgid / NXCD; wgid = (xcd < r ? xcd * (q + 1) : r * (q + 1) + (xcd - r) * q) + off; }
        const int nig = WGM * nN, gid = wgid / nig, fm = gid * WGM, gsz = (nM - fm) < WGM ? (nM - fm) : WGM;
        u.pm = fm + ((wgid % nig) % gsz); u.pn = (wgid % nig) / gsz; return true;
    }
    __device__ __forceinline__ void a_ready(const Unit&) const {}
    __device__ __forceinline__ void done(const Unit&) const {}
};

__device__ __forceinline__ unsigned cvt_pk_bf16(float lo, float hi) { unsigned r; asm volatile("v_cvt_pk_bf16_f32 %0, %1, %2" : "=v"(r) : "v"(lo), "v"(hi)); return r; }
__device__ __forceinline__ float bf_lo(unsigned w) { return __uint_as_float(w << 16); }
__device__ __forceinline__ float bf_hi(unsigned w) { return __uint_as_float(w & 0xffff0000u); }
__device__ __forceinline__ float fsigmoid(float x) { return __builtin_amdgcn_rcpf(1.0f + __expf(-x)); }
__device__ __forceinline__ float fsilu(float x) { return x * fsigmoid(x); }

template <class Epi, class Sched, bool ALIGN_EPI = false, bool SP2 = false>
__device__ __forceinline__ void gemm_phase(PG8_LAS unsigned char* lds, const Gemm g, const Sched& S, const Epi& E) {
    const int tid = threadIdx.x, wid = __builtin_amdgcn_readfirstlane(tid >> 6), lane = tid & 63, wr = wid >> 2, wc = wid & 3, fr = lane & 15, fq = lane >> 4;
    const int K = g.K, nt = K / BK;
    unsigned voffA[2], voffB[2];
#pragma unroll
    for (int i = 0; i < 2; ++i) { int R, C; stage_rc(tid * 16 + i * 8192, R, C); const int Rb = Epi::PERM ? ((R & ~31) + perm32(R & 31)) : R;
        voffA[i] = (unsigned)(R * g.lda + C) * 2u; voffB[i] = (unsigned)(Rb * g.ldb + C) * 2u; }
    const size_t kstep = (size_t)(BK * 2);
    const size_t hstepA = (size_t)HALF * g.lda * 2, hstepB = (size_t)HALF * g.ldb * 2;
    const size_t tstepA = 2 * hstepA, tstepB = 2 * hstepB;
    const unsigned ldsw = (unsigned)wid * 1024u;
    const int aoff = lds_byte(wr * 64 + fr, fq * 8), boff = lds_byte(wc * 32 + fr, fq * 8);
#define PG8_SA(b, h) (((b) * 2 + (h)) * HTB)
#define PG8_SB(b, h) ((4 + (b) * 2 + (h)) * HTB)
#define PG8_STAGE(bufoff, gbase, voff) do { _Pragma("unroll") for (int _i = 0; _i < 2; ++_i) \
        __builtin_amdgcn_global_load_lds((const unsigned*)((const char*)(gbase) + (voff)[_i]), (PG8_LAS unsigned*)(lds + (bufoff) + ldsw + _i * 8192), 16, 0, 0); } while (0)
#define PG8_LDA(dst, b, h) do { _Pragma("unroll") for (int m = 0; m < 4; ++m) _Pragma("unroll") for (int k = 0; k < 2; ++k) dst[m][k] = *(const PG8_LAS bf16x8*)(lds + PG8_SA(b, h) + aoff + m * 2048 + k * 1024); } while (0)
#define PG8_LDB(dst, b, h) do { _Pragma("unroll") for (int n = 0; n < 2; ++n) _Pragma("unroll") for (int k = 0; k < 2; ++k) dst[n][k] = *(const PG8_LAS bf16x8*)(lds + PG8_SB(b, h) + boff + n * 2048 + k * 1024); } while (0)
#define PG8_MMA(ai, bj, At, Bt) do { __builtin_amdgcn_s_setprio(1); _Pragma("unroll") for (int m = 0; m < 4; ++m) _Pragma("unroll") for (int n = 0; n < 2; ++n) _Pragma("unroll") for (int k = 0; k < 2; ++k) \
        acc[ai][bj][m][n] = __builtin_amdgcn_mfma_f32_16x16x32_bf16(Bt[n][k], At[m][k], acc[ai][bj][m][n], 0, 0, 0); __builtin_amdgcn_s_setprio(0); } while (0)
#define PG8_WAIT_V(n) asm volatile("s_waitcnt vmcnt(" #n ")" ::: "memory")
#define PG8_WAIT_L(n) asm volatile("s_waitcnt lgkmcnt(" #n ")" ::: "memory")
#define PG8_BAR __builtin_amdgcn_s_barrier()
#define PG8_SCHED __builtin_amdgcn_sched_barrier(0)
#define PG8_ABASE(u) ((const char*)g.A + (size_t)(u).pm * tstepA + (g.agrp_stride ? (size_t)(((u).pn >> g.agrp_shift) * g.agrp_stride) * 2 : (size_t)0))
    Unit cur, nxt; int ui = 0;
    if (!S.next(0, cur)) return;
    f32x4 acc[2][2][4][2];
#pragma unroll
    for (int a = 0; a < 2; ++a)
#pragma unroll
        for (int b = 0; b < 2; ++b)
#pragma unroll
            for (int m = 0; m < 4; ++m)
#pragma unroll
                for (int n = 0; n < 2; ++n) acc[a][b][m][n] = (f32x4){0.f, 0.f, 0.f, 0.f};
    bf16x8 At[4][2], B0[2][2], B1[2][2];
    const char* cA = PG8_ABASE(cur); const char* cB = (const char*)g.Bt + (size_t)cur.pn * tstepB;
    S.a_ready(cur);
    if constexpr (SP2) {
        PG8_STAGE(PG8_SB(0, 0), cB, voffB); PG8_STAGE(PG8_SB(0, 1), cB + hstepB, voffB); PG8_STAGE(PG8_SA(0, 0), cA, voffA); PG8_STAGE(PG8_SA(0, 1), cA + hstepA, voffA);
        if (wr == 1) PG8_BAR;
        PG8_WAIT_V(2); PG8_BAR;
        PG8_STAGE(PG8_SB(1, 0), cB + kstep, voffB); PG8_STAGE(PG8_SA(1, 0), cA + kstep, voffA); PG8_STAGE(PG8_SB(1, 1), cB + hstepB + kstep, voffB);
        PG8_WAIT_V(6); PG8_BAR;
    } else {
        PG8_STAGE(PG8_SB(0, 0), cB, voffB); PG8_STAGE(PG8_SA(0, 0), cA, voffA); PG8_STAGE(PG8_SB(0, 1), cB + hstepB, voffB); PG8_STAGE(PG8_SA(0, 1), cA + hstepA, voffA);
        if (wr == 1) PG8_BAR;
        PG8_WAIT_V(4); PG8_BAR;
        PG8_STAGE(PG8_SB(1, 0), cB + kstep, voffB); PG8_STAGE(PG8_SA(1, 0), cA + kstep, voffA); PG8_STAGE(PG8_SB(1, 1), cB + hstepB + kstep, voffB);
        PG8_WAIT_V(6); PG8_BAR;
    }
    for (;;) {
        const bool has_next = S.next(ui + 1, nxt);
        const char* nA = has_next ? PG8_ABASE(nxt) : cA; const char* nB = has_next ? (const char*)g.Bt + (size_t)nxt.pn * tstepB : cB;
        for (int t = 0; t < nt; t += 2) {
            const bool last = (t == nt - 2);
            const char* a1 = cA + (size_t)(t + 1) * kstep;
            const char* a2 = last ? nA : cA + (size_t)(t + 2) * kstep; const char* b2 = last ? nB : cB + (size_t)(t + 2) * kstep;
            const char* a3 = a2 + kstep; const char* b3 = b2 + kstep;
            if (last && has_next) S.a_ready(nxt);
            if constexpr (SP2) {
            PG8_LDB(B0, 0, 0); PG8_LDB(B1, 0, 1); PG8_SCHED; PG8_LDA(At, 0, 0); PG8_STAGE(PG8_SA(1, 1), a1 + hstepA, voffA);
            PG8_WAIT_V(8); PG8_WAIT_L(0); PG8_BAR; PG8_MMA(0, 0, At, B0); PG8_MMA(0, 1, At, B1); PG8_BAR; PG8_SCHED;
            PG8_LDA(At, 0, 1); PG8_STAGE(PG8_SB(0, 0), b2, voffB); PG8_STAGE(PG8_SB(0, 1), b2 + hstepB, voffB); PG8_STAGE(PG8_SA(0, 0), a2, voffA);
            PG8_WAIT_V(8); PG8_WAIT_L(0); PG8_BAR; PG8_MMA(1, 0, At, B0); PG8_MMA(1, 1, At, B1); PG8_BAR; PG8_SCHED;
            PG8_LDB(B0, 1, 0); PG8_LDB(B1, 1, 1); PG8_SCHED; PG8_LDA(At, 1, 0); PG8_STAGE(PG8_SA(0, 1), a2 + hstepA, voffA);
            PG8_WAIT_V(8); PG8_WAIT_L(0); PG8_BAR; PG8_MMA(0, 0, At, B0); PG8_MMA(0, 1, At, B1); PG8_BAR; PG8_SCHED;
            PG8_LDA(At, 1, 1); PG8_STAGE(PG8_SB(1, 0), b3, voffB); PG8_STAGE(PG8_SB(1, 1), b3 + hstepB, voffB); PG8_STAGE(PG8_SA(1, 0), a3, voffA);
            PG8_WAIT_V(8); PG8_WAIT_L(0); PG8_BAR; PG8_MMA(1, 0, At, B0); PG8_MMA(1, 1, At, B1); PG8_BAR; PG8_SCHED;
            } else {
            PG8_LDB(B0, 0, 0); PG8_SCHED; PG8_LDA(At, 0, 0); PG8_STAGE(PG8_SA(1, 1), a1 + hstepA, voffA);
            PG8_WAIT_L(8); PG8_BAR; PG8_WAIT_L(0); PG8_MMA(0, 0, At, B0); PG8_BAR; PG8_SCHED;
            PG8_LDB(B1, 0, 1); PG8_STAGE(PG8_SB(0, 0), b2, voffB);
            PG8_BAR; PG8_WAIT_L(0); PG8_MMA(0, 1, At, B1); PG8_BAR;
            PG8_LDA(At, 0, 1); PG8_STAGE(PG8_SA(0, 0), a2, voffA);
            PG8_BAR; PG8_WAIT_L(0); PG8_MMA(1, 0, At, B0); PG8_BAR; PG8_SCHED;
            PG8_STAGE(PG8_SB(0, 1), b2 + hstepB, voffB);
            PG8_WAIT_V(6); PG8_BAR; PG8_MMA(1, 1, At, B1); PG8_BAR;
            PG8_LDB(B0, 1, 0); PG8_SCHED; PG8_LDA(At, 1, 0); PG8_STAGE(PG8_SA(0, 1), a2 + hstepA, voffA);
            PG8_WAIT_L(8); PG8_BAR; PG8_WAIT_L(0); PG8_MMA(0, 0, At, B0); PG8_BAR; PG8_SCHED;
            PG8_LDB(B1, 1, 1); PG8_STAGE(PG8_SB(1, 0), b3, voffB);
            PG8_BAR; PG8_WAIT_L(0); PG8_MMA(0, 1, At, B1); PG8_BAR;
            PG8_LDA(At, 1, 1); PG8_STAGE(PG8_SA(1, 0), a3, voffA);
            PG8_BAR; PG8_WAIT_L(0); PG8_MMA(1, 0, At, B0); PG8_BAR; PG8_SCHED;
            PG8_STAGE(PG8_SB(1, 1), b3 + hstepB, voffB);
            PG8_WAIT_V(6); PG8_BAR; PG8_MMA(1, 1, At, B1); PG8_BAR;
            }
        }
        if constexpr (ALIGN_EPI) { if (wr == 0) PG8_BAR; }
        E(acc, cur, wr, wc, fr, fq); S.done(cur);
        if (!has_next) break;
#pragma unroll
        for (int a = 0; a < 2; ++a)
#pragma unroll
            for (int b = 0; b < 2; ++b)
#pragma unroll
                for (int m = 0; m < 4; ++m)
#pragma unroll
                    for (int n = 0; n < 2; ++n) acc[a][b][m][n] = (f32x4){0.f, 0.f, 0.f, 0.f};
        cur = nxt; cA = nA; cB = nB; ++ui;
        if constexpr (ALIGN_EPI) { if (wr == 1) PG8_BAR; }
    }
    PG8_WAIT_V(0);
    if constexpr (!ALIGN_EPI) { if (wr == 0) PG8_BAR; }
    PG8_BAR;
#undef PG8_ABASE
#undef PG8_SA
#undef PG8_SB
#undef PG8_STAGE
#undef PG8_LDA
#undef PG8_LDB
#undef PG8_MMA
#undef PG8_WAIT_V
#undef PG8_WAIT_L
#undef PG8_BAR
#undef PG8_SCHED
}
}

constexpr int NWAVES = 8;
constexpr int T = 8192, D = 4096, PW = 2048, HW = 2048, NH = 16, HD = 128, DFF = 11008;
constexpr int NIN = PW + 4 * HW + 2 * D;
constexpr float EPS = 1e-6f;
constexpr int NPHASE = 11;
constexpr int N_LAUNCHES = MK_N_LAUNCHES;

constexpr size_t MiB = 1u << 20;
constexpr size_t WS_CTL = 0, CTL_ZERO_BYTES = 1 * MiB;
constexpr size_t WS_WIN = 1 * MiB;
constexpr size_t WS_WPG = WS_WIN + 144 * MiB;
constexpr size_t WS_WUP = WS_WPG + 2 * MiB;
constexpr size_t WS_WUH = WS_WUP + 16 * MiB;
constexpr size_t WS_WO = WS_WUH + 16 * MiB;
constexpr size_t WS_WGU = WS_WO + 32 * MiB;
constexpr size_t WS_WD = WS_WGU + 172 * MiB;
constexpr size_t WS_U = WS_WD + 86 * MiB;
constexpr size_t WS_PROJ = WS_U + 64 * MiB;
constexpr size_t WS_Z = WS_PROJ, WS_QS = WS_Z + 32 * MiB, WS_G = WS_QS + 32 * MiB, WS_KK = WS_G + 32 * MiB, WS_V = WS_KK + 32 * MiB, WS_OG = WS_V + 32 * MiB;
constexpr size_t WS_GA = WS_OG + 32 * MiB, WS_GB = WS_GA + 64 * MiB;
constexpr size_t WS_ACT = WS_PROJ;
constexpr size_t WS_P = WS_PROJ + 320 * MiB;
constexpr size_t WS_YP = WS_P + 32 * MiB, WS_YH = WS_YP + 32 * MiB;
constexpr size_t WS_H1B = WS_YH + 32 * MiB;
constexpr size_t WS_O = WS_H1B + 64 * MiB;
constexpr size_t WS_HU = WS_O, WS_HS = WS_O + 16 * MiB, WS_HD = WS_O + 32 * MiB;
constexpr size_t WS_SSQ1 = WS_O + 64 * MiB, WS_SSQ2 = WS_SSQ1 + 2 * MiB, WS_RS1 = WS_SSQ2 + 2 * MiB;
constexpr size_t WS_END = WS_RS1 + 1 * MiB;
static_assert(WS_ACT + (size_t)T * DFF * 2 <= WS_P, "ACT overlay fits the projection region");

constexpr int RING_OFF = 0, RING_BYTES = 131072;
constexpr int LDSCTL_OFF = RING_BYTES, MISC_OFF = LDSCTL_OFF + 320;
constexpr int RS_OFF = LDSCTL_OFF + 1024, RS_PANELS = 8;
constexpr int LDS_BYTES = 147456;
static_assert(MISC_OFF + 128 <= RS_OFF && RS_OFF + RS_PANELS * 1024 <= LDS_BYTES, "LDS map");

#define GAS __attribute__((address_space(1)))
#define LAS __attribute__((address_space(3)))
typedef unsigned short bf16;
typedef unsigned v4u __attribute__((ext_vector_type(4)));
typedef unsigned v2u __attribute__((ext_vector_type(2)));
typedef float f32x4 __attribute__((ext_vector_type(4)));
typedef GAS unsigned gu32;
#define RLX_AGENT __ATOMIC_RELAXED, __HIP_MEMORY_SCOPE_AGENT
#define LDS_WAIT() asm volatile("s_waitcnt lgkmcnt(0)" ::: "memory")
#define VM_WAIT() asm volatile("s_waitcnt vmcnt(0)" ::: "memory")
__device__ __forceinline__ unsigned f2bf(float f) { unsigned u = __builtin_bit_cast(unsigned, f); return (u + 0x7fffu + ((u >> 16) & 1u)) >> 16; }
__device__ __forceinline__ unsigned pk2(float lo, float hi) { return f2bf(lo) | (f2bf(hi) << 16); }
__device__ __forceinline__ float bf2f(unsigned short b) { return __uint_as_float(((unsigned)b) << 16); }

#define XB_TMO      128
#define XB_XCNT(j)  (256  + 64 * (j))
#define XB_XSUB(j)  (1280 + 64 * (j))
#define XB_XGEN(j)  (2304 + 64 * (j))
#define XB_TOP      3328
#define XB_TOPGEN   3392
#define XCD_BAR_WORDS 3456
#define XB_SPIN_CAP (1u << 18)
__device__ __forceinline__ unsigned xb_ld(unsigned* p)              { return __hip_atomic_load(p, __ATOMIC_RELAXED, __HIP_MEMORY_SCOPE_AGENT); }
__device__ __forceinline__ unsigned xb_add(unsigned* p, unsigned v) { return __hip_atomic_fetch_add(p, v, __ATOMIC_RELAXED, __HIP_MEMORY_SCOPE_AGENT); }
__device__ __forceinline__ unsigned xb_xcc_id() { return (unsigned)__builtin_amdgcn_s_getreg((3 << 11) | 20) & 0xFu; }
#define XB_SPIN(cond, bar) do { unsigned _sp = 0; while (cond) { __builtin_amdgcn_s_sleep(1); \
    if ((++_sp & 255u) == 0u) { if (xb_ld(&(bar)[XB_TMO])) break; if (_sp > XB_SPIN_CAP) { atomicAdd(&(bar)[XB_TMO], 1u); break; } } } } while (0)
struct XcdBarrier { unsigned* bar; unsigned x; volatile LAS unsigned* st; };
__device__ __forceinline__ XcdBarrier xcd_barrier_post(unsigned* bar, volatile LAS unsigned* st) {
    XcdBarrier b; b.bar = bar; b.x = xb_xcc_id(); b.st = st;
    if (threadIdx.x == 0) (void)xb_add(&bar[XB_XCNT(b.x)], 1u);
    return b;
}
__device__ __forceinline__ void xcd_barrier_complete(unsigned* bar, unsigned x, unsigned& nloc, unsigned& nx) {
    const unsigned G = gridDim.x * gridDim.y * gridDim.z;
    unsigned sum, cnt, mine, sp = 0u;
    for (;;) {
        sum = 0u; cnt = 0u; mine = 0u;
#pragma unroll
        for (unsigned j = 0; j < 16; ++j) { const unsigned c = xb_ld(&bar[XB_XCNT(j)]); sum += c; cnt += (c > 0u) ? 1u : 0u; mine = (j == x) ? c : mine; }
        if (sum == G) break;
        __builtin_amdgcn_s_sleep(1);
        if ((++sp & 255u) == 0u) { if (xb_ld(&bar[XB_TMO])) break; if (sp > XB_SPIN_CAP) { atomicAdd(&bar[XB_TMO], 1u); break; } }
    }
    nloc = mine > 0u ? mine : 1u; nx = cnt > 0u ? cnt : 1u;
}
__device__ __forceinline__ void xcd_barrier(const XcdBarrier& b) {
    asm volatile("s_waitcnt vmcnt(0)" ::: "memory");
    __syncthreads();
    if (threadIdx.x == 0) {
        unsigned* bar = b.bar;
        __builtin_amdgcn_s_waitcnt(0);
        unsigned nloc = b.st[0], nx = b.st[1];
        if (nloc == 0u) { xcd_barrier_complete(bar, b.x, nloc, nx); b.st[0] = nloc; b.st[1] = nx; }
        const unsigned old = xb_add(&bar[XB_XSUB(b.x)], 1u);
        const unsigned gen = old / nloc;
        if (old + 1u == (gen + 1u) * nloc) {
            __builtin_amdgcn_fence(__ATOMIC_RELEASE, "agent");
            asm volatile("s_waitcnt vmcnt(0)" ::: "memory");
            const unsigned og = xb_add(&bar[XB_TOP], 1u);
            const unsigned tg = og / nx;
            if (og + 1u == (tg + 1u) * nx) xb_add(&bar[XB_TOPGEN], 1u);
            else XB_SPIN(xb_ld(&bar[XB_TOPGEN]) == tg, bar);
            __builtin_amdgcn_fence(__ATOMIC_ACQUIRE, "agent");
            xb_add(&bar[XB_XGEN(b.x)], 1u);
            asm volatile("s_waitcnt vmcnt(0)" ::: "memory");
        } else {
            XB_SPIN(xb_ld(&bar[XB_XGEN(b.x)]) == gen, bar);
            __builtin_amdgcn_fence(__ATOMIC_ACQUIRE, "agent");
            asm volatile("s_waitcnt vmcnt(0)" ::: "memory");
        }
    }
    __syncthreads();
}

using pg8::Unit; using pg8::cvt_pk_bf16; using pg8::fsigmoid; using pg8::fsilu; using pg8::bf_lo; using pg8::bf_hi;
constexpr int BM = 256, HALF = 128;

struct EpiProj {
    static constexpr bool PERM = true;
    bf16* PROJ; const float* lbp;
    __device__ __forceinline__ void operator()(const f32x4 (&acc)[2][2][4][2], const Unit& u, int wr, int wc, int fr, int fq) const {
        const int row0 = u.pm * BM + wr * 64 + fr; const int cls = u.pn >> 3;
        int ldc, colt; size_t toff;
        if (cls < 5) { ldc = 2048; colt = (u.pn & 7) * 256; toff = (size_t)(cls + (cls >= 3 ? 1 : 0)) * ((size_t)T * 2048); }
        else { ldc = 4096; colt = (u.pn - (cls < 7 ? 40 : 56)) * 256; toff = (size_t)6 * ((size_t)T * 2048) + (cls < 7 ? (size_t)0 : (size_t)T * 4096); }
        bf16* base = PROJ + toff; bf16* G = PROJ + (size_t)2 * T * 2048; bf16* KK = PROJ + (size_t)3 * T * 2048;
        const int col0 = colt + wc * 32 + 8 * fq;
        if (cls == 2) {
            float lb[2][8];
#pragma unroll
            for (int bj = 0; bj < 2; ++bj) {
                const f32x4 p0a = *(const f32x4*)(lbp + col0 + bj * HALF), p0b = *(const f32x4*)(lbp + col0 + bj * HALF + 4);
                const f32x4 p1a = *(const f32x4*)(lbp + HW + col0 + bj * HALF), p1b = *(const f32x4*)(lbp + HW + col0 + bj * HALF + 4);
#pragma unroll
                for (int j = 0; j < 4; ++j) { lb[bj][j] = __builtin_amdgcn_rcpf(1.0f + __expf(p1a[j] - p0a[j])); lb[bj][4 + j] = __builtin_amdgcn_rcpf(1.0f + __expf(p1b[j] - p0b[j])); }
            }
#pragma unroll
            for (int ai = 0; ai < 2; ++ai)
#pragma unroll
                for (int m = 0; m < 4; ++m) { const size_t ro = (size_t)(row0 + ai * HALF + m * 16) * 2048 + col0;
#pragma unroll
                    for (int bj = 0; bj < 2; ++bj) { float gl[8], kv[8];
#pragma unroll
                        for (int n = 0; n < 2; ++n)
#pragma unroll
                            for (int j = 0; j < 4; ++j) { const float x = fminf(fmaxf(acc[ai][bj][m][n][j], -80.f), 80.f); const float e = __expf(-x); const float sg = __builtin_amdgcn_rcpf(1.0f + e); const float l = lb[bj][4 * n + j];
                                const float f = l + (1.0f - l) * sg; gl[4 * n + j] = __log2f(f); kv[4 * n + j] = (1.0f - l) * (e * sg); }
                        pg8::u32x4 w; w.x = cvt_pk_bf16(gl[0], gl[1]); w.y = cvt_pk_bf16(gl[2], gl[3]); w.z = cvt_pk_bf16(gl[4], gl[5]); w.w = cvt_pk_bf16(gl[6], gl[7]);
                        *(pg8::u32x4*)(G + ro + bj * HALF) = w;
                        w.x = cvt_pk_bf16(kv[0], kv[1]); w.y = cvt_pk_bf16(kv[2], kv[3]); w.z = cvt_pk_bf16(kv[4], kv[5]); w.w = cvt_pk_bf16(kv[6], kv[7]);
                        *(pg8::u32x4*)(KK + ro + bj * HALF) = w; } }
            return;
        }
        const int act = (cls == 0 || cls == 3) ? 0 : (cls == 1 || cls == 4) ? 1 : 2;
#pragma unroll
        for (int ai = 0; ai < 2; ++ai)
#pragma unroll
            for (int m = 0; m < 4; ++m) { bf16* rowp = base + (size_t)(row0 + ai * HALF + m * 16) * ldc + col0;
#pragma unroll
                for (int bj = 0; bj < 2; ++bj) { f32x4 v0 = acc[ai][bj][m][0], v1 = acc[ai][bj][m][1];
                    if (act != 0) {
#pragma unroll
                        for (int j = 0; j < 4; ++j) { const float s0 = fsigmoid(v0[j]), s1 = fsigmoid(v1[j]); v0[j] = act == 1 ? v0[j] * s0 : s0; v1[j] = act == 1 ? v1[j] * s1 : s1; } }
                    pg8::u32x4 w; w.x = cvt_pk_bf16(v0[0], v0[1]); w.y = cvt_pk_bf16(v0[2], v0[3]); w.z = cvt_pk_bf16(v1[0], v1[1]); w.w = cvt_pk_bf16(v1[2], v1[3]);
                    *(pg8::u32x4*)(rowp + bj * HALF) = w; } }
    }
};
struct EpiScaleBf16 {
    static constexpr bool PERM = true;
    bf16* O; int ldc; const float* scale;
    __device__ __forceinline__ void operator()(const f32x4 (&acc)[2][2][4][2], const Unit& u, int wr, int wc, int fr, int fq) const {
        const int row0 = u.pm * BM + wr * 64 + fr, col0 = u.pn * BM + wc * 32 + 8 * fq;
        f32x4 sv[2][2];
#pragma unroll
        for (int bj = 0; bj < 2; ++bj)
#pragma unroll
            for (int n = 0; n < 2; ++n) sv[bj][n] = *(const f32x4*)(scale + col0 + bj * HALF + 4 * n);
#pragma unroll
        for (int ai = 0; ai < 2; ++ai)
#pragma unroll
            for (int m = 0; m < 4; ++m) { bf16* rowp = O + (size_t)(row0 + ai * HALF + m * 16) * ldc + col0;
#pragma unroll
                for (int bj = 0; bj < 2; ++bj) { const f32x4 v0 = acc[ai][bj][m][0] * sv[bj][0], v1 = acc[ai][bj][m][1] * sv[bj][1];
                    pg8::u32x4 w; w.x = cvt_pk_bf16(v0[0], v0[1]); w.y = cvt_pk_bf16(v0[2], v0[3]); w.z = cvt_pk_bf16(v1[0], v1[1]); w.w = cvt_pk_bf16(v1[2], v1[3]);
                    *(pg8::u32x4*)(rowp + bj * HALF) = w; } }
    }
};
struct EpiGateF32 {
    static constexpr bool PERM = true;
    float* X; const bf16* GT;
    __device__ __forceinline__ void operator()(const f32x4 (&acc)[2][2][4][2], const Unit& u, int wr, int wc, int fr, int fq) const {
        const int row0 = u.pm * BM + wr * 64 + fr, col0 = u.pn * BM + wc * 32 + 8 * fq;
#pragma unroll
        for (int ai = 0; ai < 2; ++ai)
#pragma unroll
            for (int m = 0; m < 4; ++m) { const size_t ro = (size_t)(row0 + ai * HALF + m * 16) * D + col0;
#pragma unroll
                for (int bj = 0; bj < 2; ++bj) { const pg8::u32x4 gw = *(const pg8::u32x4*)(GT + ro + bj * HALF);
                    f32x4 v0 = acc[ai][bj][m][0], v1 = acc[ai][bj][m][1];
                    v0[0] *= bf_lo(gw.x); v0[1] *= bf_hi(gw.x); v0[2] *= bf_lo(gw.y); v0[3] *= bf_hi(gw.y);
                    v1[0] *= bf_lo(gw.z); v1[1] *= bf_hi(gw.z); v1[2] *= bf_lo(gw.w); v1[3] *= bf_hi(gw.w);
                    *(f32x4*)(X + ro + bj * HALF) = v0; *(f32x4*)(X + ro + bj * HALF + 4) = v1; } }
    }
};
struct EpiGateAddBf16 {
    static constexpr bool PERM = true;
    const float* X; const bf16* GT; bf16* O;
    __device__ __forceinline__ void operator()(const f32x4 (&acc)[2][2][4][2], const Unit& u, int wr, int wc, int fr, int fq) const {
        const int row0 = u.pm * BM + wr * 64 + fr, col0 = u.pn * BM + wc * 32 + 8 * fq;
#pragma unroll
        for (int ai = 0; ai < 2; ++ai)
#pragma unroll
            for (int m = 0; m < 4; ++m) { const size_t ro = (size_t)(row0 + ai * HALF + m * 16) * D + col0;
#pragma unroll
                for (int bj = 0; bj < 2; ++bj) { const pg8::u32x4 gw = *(const pg8::u32x4*)(GT + ro + bj * HALF);
                    const f32x4 x0 = *(const f32x4*)(X + ro + bj * HALF), x1 = *(const f32x4*)(X + ro + bj * HALF + 4);
                    f32x4 v0 = acc[ai][bj][m][0], v1 = acc[ai][bj][m][1];
                    v0[0] = x0[0] + v0[0] * bf_lo(gw.x); v0[1] = x0[1] + v0[1] * bf_hi(gw.x); v0[2] = x0[2] + v0[2] * bf_lo(gw.y); v0[3] = x0[3] + v0[3] * bf_hi(gw.y);
                    v1[0] = x1[0] + v1[0] * bf_lo(gw.z); v1[1] = x1[1] + v1[1] * bf_hi(gw.z); v1[2] = x1[2] + v1[2] * bf_lo(gw.w); v1[3] = x1[3] + v1[3] * bf_hi(gw.w);
                    pg8::u32x4 w; w.x = cvt_pk_bf16(v0[0], v0[1]); w.y = cvt_pk_bf16(v0[2], v0[3]); w.z = cvt_pk_bf16(v1[0], v1[1]); w.w = cvt_pk_bf16(v1[2], v1[3]);
                    *(pg8::u32x4*)(O + ro + bj * HALF) = w; } }
    }
};
template <bool WITH_HB> struct EpiResid {
    static constexpr bool PERM = true;
    const float* R; float* H; bf16* HB; const float* gain; float* SSQ;
    __device__ __forceinline__ void operator()(const f32x4 (&acc)[2][2][4][2], const Unit& u, int wr, int wc, int fr, int fq) const {
        const int row0 = u.pm * BM + wr * 64 + fr, col0 = u.pn * BM + wc * 32 + 8 * fq;
        f32x4 gv[2][2];
        if (WITH_HB) {
#pragma unroll
            for (int bj = 0; bj < 2; ++bj)
#pragma unroll
                for (int n = 0; n < 2; ++n) gv[bj][n] = *(const f32x4*)(gain + col0 + bj * HALF + 4 * n);
        }
#pragma unroll
        for (int ai = 0; ai < 2; ++ai)
#pragma unroll
            for (int m = 0; m < 4; ++m) { const int row = row0 + ai * HALF + m * 16; const size_t ro = (size_t)row * D + col0; float ss = 0.f;
#pragma unroll
                for (int bj = 0; bj < 2; ++bj) {
                    const f32x4 h0 = *(const f32x4*)(R + ro + bj * HALF) + acc[ai][bj][m][0], h1 = *(const f32x4*)(R + ro + bj * HALF + 4) + acc[ai][bj][m][1];
                    ss += (h0[0] * h0[0] + h0[1] * h0[1]) + (h0[2] * h0[2] + h0[3] * h0[3]) + (h1[0] * h1[0] + h1[1] * h1[1]) + (h1[2] * h1[2] + h1[3] * h1[3]);
                    *(f32x4*)(H + ro + bj * HALF) = h0; *(f32x4*)(H + ro + bj * HALF + 4) = h1;
                    if (WITH_HB) { const f32x4 a0 = h0 * gv[bj][0], a1 = h1 * gv[bj][1];
                        pg8::u32x4 w; w.x = cvt_pk_bf16(a0[0], a0[1]); w.y = cvt_pk_bf16(a0[2], a0[3]); w.z = cvt_pk_bf16(a1[0], a1[1]); w.w = cvt_pk_bf16(a1[2], a1[3]);
                        *(pg8::u32x4*)(HB + ro + bj * HALF) = w; }
                }
                ss += __shfl_xor(ss, 16); ss += __shfl_xor(ss, 32);
                if (fq == 0) SSQ[(size_t)(u.pn * 4 + wc) * T + row] = ss;
            }
    }
};
struct EpiNull {
    static constexpr bool PERM = true;
    __device__ __forceinline__ void operator()(const f32x4 (&acc)[2][2][4][2], const Unit&, int, int, int, int) const {
#pragma unroll
        for (int ai = 0; ai < 2; ++ai)
#pragma unroll
            for (int bj = 0; bj < 2; ++bj)
#pragma unroll
                for (int m = 0; m < 4; ++m)
#pragma unroll
                    for (int n = 0; n < 2; ++n) asm volatile("" :: "v"(acc[ai][bj][m][n]));
    }
};
struct EpiSwiGLU {
    static constexpr bool PERM = true;
    bf16* O; const LAS float* RS; int pm_lo;
    __device__ __forceinline__ void operator()(const f32x4 (&acc)[2][2][4][2], const Unit& u, int wr, int wc, int fr, int fq) const {
        const int row0 = u.pm * BM + wr * 64 + fr, col0 = u.pn * HALF + wc * 32 + 8 * fq;
#pragma unroll
        for (int ai = 0; ai < 2; ++ai)
#pragma unroll
            for (int m = 0; m < 4; ++m) { const int row = row0 + ai * HALF + m * 16; const float r = RS[row - pm_lo * BM];
                float o[8];
#pragma unroll
                for (int n = 0; n < 2; ++n)
#pragma unroll
                    for (int j = 0; j < 4; ++j) { const float gt = acc[ai][0][m][n][j] * r, up = acc[ai][1][m][n][j] * r; o[4 * n + j] = fsilu(gt) * up; }
                pg8::u32x4 w; w.x = cvt_pk_bf16(o[0], o[1]); w.y = cvt_pk_bf16(o[2], o[3]); w.z = cvt_pk_bf16(o[4], o[5]); w.w = cvt_pk_bf16(o[6], o[7]);
                *(pg8::u32x4*)(O + (size_t)row * DFF + col0) = w; }
    }
};

struct Frame {
    LAS unsigned char* lds;
    volatile LAS unsigned* MISC;
    gu32* ctl;
    int tid, lane, wave;
    int vcu, G;
};
__device__ __forceinline__ float wave_sum(float v) {
#pragma unroll
    for (int o = 1; o < 64; o <<= 1) v += __shfl_xor(v, o);
    return v;
}
__device__ __forceinline__ void p0_transpose_item(const float* W, int N, bf16* WT, int ldt, int rowmode, LAS float* scr, int kb, int nb, int lane) {
    const int k0 = 64 * kb, n0 = 32 * nb;
    const int lk = lane >> 3, ln = (lane & 7) * 4;
#pragma unroll
    for (int i = 0; i < 8; ++i) { const int kk = 8 * i + lk; const f32x4 v = *(const GAS f32x4*)(W + (size_t)(k0 + kk) * N + n0 + ln);
        scr[kk * 33 + ln] = v[0]; scr[kk * 33 + ln + 1] = v[1]; scr[kk * 33 + ln + 2] = v[2]; scr[kk * 33 + ln + 3] = v[3]; }
    LDS_WAIT(); asm volatile("" ::: "memory");
    const int c = lane & 7;
#pragma unroll
    for (int j = 0; j < 4; ++j) { const int n = (lane >> 3) + 8 * j; const LAS float* s = scr + (8 * c) * 33 + n;
        v4u o; o.x = pk2(s[0 * 33], s[1 * 33]); o.y = pk2(s[2 * 33], s[3 * 33]); o.z = pk2(s[4 * 33], s[5 * 33]); o.w = pk2(s[6 * 33], s[7 * 33]);
        const int ng = n0 + n; const int row = rowmode == 0 ? ng : ((ng >> 7) * 256 + (rowmode == 2 ? 128 : 0) + (ng & 127));
        *(GAS v4u*)(WT + (size_t)row * ldt + k0 + 8 * c) = o; }
    LDS_WAIT(); asm volatile("" ::: "memory");
}
__device__ __forceinline__ void p0_transpose_matrix(const float* W, int K, int N, bf16* WT, int ldt, int rowmode, LAS float* scr, int gw, int NGW, int lane) {
    const int nblk = N / 32, nitems = (K / 64) * nblk;
    for (int it = gw; it < nitems; it += NGW) p0_transpose_item(W, N, WT, ldt, rowmode, scr, it / nblk, it % nblk, lane);
}

template <int W>
__device__ __forceinline__ void pool_item(const bf16* Z, bf16* P, int t4, int c8) {
    v4u rows[W + 3];
#pragma unroll
    for (int i = 0; i < W + 3; ++i) { const int t = t4 - (W - 1) + i; rows[i] = (t >= 0) ? *(const GAS v4u*)(Z + (size_t)t * PW + c8) : (v4u){0u, 0u, 0u, 0u}; }
    float s[8];
#pragma unroll
    for (int j = 0; j < 8; ++j) s[j] = 0.f;
#pragma unroll
    for (int i = 0; i < W - 1; ++i) { const v4u q = rows[i];
        s[0] += pg8::bf_lo(q.x); s[1] += pg8::bf_hi(q.x); s[2] += pg8::bf_lo(q.y); s[3] += pg8::bf_hi(q.y); s[4] += pg8::bf_lo(q.z); s[5] += pg8::bf_hi(q.z); s[6] += pg8::bf_lo(q.w); s[7] += pg8::bf_hi(q.w); }
#pragma unroll
    for (int r = 0; r < 4; ++r) {
        const v4u q = rows[W - 1 + r]; const float z[8] = {pg8::bf_lo(q.x), pg8::bf_hi(q.x), pg8::bf_lo(q.y), pg8::bf_hi(q.y), pg8::bf_lo(q.z), pg8::bf_hi(q.z), pg8::bf_lo(q.w), pg8::bf_hi(q.w)};
#pragma unroll
        for (int j = 0; j < 8; ++j) s[j] += z[j];
        const int t = t4 + r; const float inv = 1.0f / (float)(t + 1 < W ? t + 1 : W);
        v4u o; o.x = pk2(s[0] * inv - z[0], s[1] * inv - z[1]); o.y = pk2(s[2] * inv - z[2], s[3] * inv - z[3]); o.z = pk2(s[4] * inv - z[4], s[5] * inv - z[5]); o.w = pk2(s[6] * inv - z[6], s[7] * inv - z[7]);
        *(GAS v4u*)(P + (size_t)t * PW + c8) = o;
        const v4u d = rows[r];
        s[0] -= pg8::bf_lo(d.x); s[1] -= pg8::bf_hi(d.x); s[2] -= pg8::bf_lo(d.y); s[3] -= pg8::bf_hi(d.y); s[4] -= pg8::bf_lo(d.z); s[5] -= pg8::bf_hi(d.z); s[6] -= pg8::bf_lo(d.w); s[7] -= pg8::bf_hi(d.w);
    }
}

constexpr int HG_QA = 0, HG_KA = HG_QA + 8704, HG_KDT = HG_KA + 8704, HG_VT = HG_KDT + 10240, HG_ST = HG_VT + 10240, HG_P = HG_ST + 34816, HG_OCT = HG_P + 2560, HG_DEC = HG_OCT + 2048, HG_SSQ = HG_DEC + 512,
              HG_RAW = HG_SSQ + 1024  , HG_YT = HG_RAW + 5 * 8192, HG_END = HG_YT + 8192;
static_assert(HG_END <= RING_BYTES, "HGRN LDS map");
typedef short bf16x8_t __attribute__((ext_vector_type(8)));
__device__ __forceinline__ float dpp_xor_sum16(float x) {
    int v = __builtin_bit_cast(int, x);
    x += __builtin_bit_cast(float, __builtin_amdgcn_update_dpp(0, v, 0xB1, 0xF, 0xF, true)); v = __builtin_bit_cast(int, x);
    x += __builtin_bit_cast(float, __builtin_amdgcn_update_dpp(0, v, 0x4E, 0xF, 0xF, true)); v = __builtin_bit_cast(int, x);
    x += __builtin_bit_cast(float, __builtin_amdgcn_update_dpp(0, v, 0x141, 0xF, 0xF, true)); v = __builtin_bit_cast(int, x);
    x += __builtin_bit_cast(float, __builtin_amdgcn_update_dpp(0, v, 0x140, 0xF, 0xF, true));
    return x;
}
#define EX2(x) __builtin_amdgcn_exp2f(x)
template <bool FULL, int VAR = 0>
__device__ __forceinline__ void hgrn_pass(LAS unsigned char* lds, int h, int sc, const bf16* QS, const bf16* Gl, const bf16* KK, const bf16* Vv, const bf16* OG, const float* hnorm,
                                          float* Ubuf, float* Dtot, const float* Sin, bf16* YH, int tid, int lane, int w) {
    const int k = tid & 127, ro = tid >> 7, fr = lane & 15, q = lane >> 4;
    const int lt = tid >> 4, lc = tid & 15;
    LAS bf16* QA = (LAS bf16*)(lds + HG_QA); LAS bf16* KA = (LAS bf16*)(lds + HG_KA); LAS bf16* KDT = (LAS bf16*)(lds + HG_KDT); LAS bf16* VT = (LAS bf16*)(lds + HG_VT);
    LAS bf16* ST = (LAS bf16*)(lds + HG_ST); LAS bf16* Pm = (LAS bf16*)(lds + HG_P); LAS float* OCT = (LAS float*)(lds + HG_OCT); LAS float* DEC = (LAS float*)(lds + HG_DEC); LAS float* SSQ = (LAS float*)(lds + HG_SSQ);
    LAS bf16* RG = (LAS bf16*)(lds + HG_RAW); LAS bf16* RK = RG + 4096; LAS bf16* RV = RG + 8192; LAS bf16* RQ = RG + 12288; LAS bf16* RO = RG + 16384; LAS bf16* YT = (LAS bf16*)(lds + HG_YT);
    const size_t item = (size_t)(h * 16 + sc);
    f32x4 S[8];
#pragma unroll
    for (int kb = 0; kb < 8; ++kb) {
        if (FULL) {
#pragma unroll
            for (int r = 0; r < 4; ++r) S[kb][r] = Sin[(item << 14) + (size_t)(16 * kb + 4 * q + r) * 128 + 16 * w + fr];
        } else S[kb] = (f32x4){0.f, 0.f, 0.f, 0.f};
    }
    if (FULL) { for (int i = tid; i < 32 * 40; i += 512) Pm[i] = 0; }
    const size_t cb = (size_t)h * HD;
    const int t00 = sc * 512;
    const float hn = FULL ? hnorm[h * HD + 16 * w + fr] : 0.f;
    float btot = 0.f;
    const size_t goff = (size_t)(t00 + lt) * HW + cb + 8 * lc;
    v4u rg = *(const GAS v4u*)(Gl + goff), rk = *(const GAS v4u*)(KK + goff), rv = *(const GAS v4u*)(Vv + goff), rq = (v4u){0u, 0u, 0u, 0u}, rog = (v4u){0u, 0u, 0u, 0u};
    if (FULL) { rq = *(const GAS v4u*)(QS + goff); rog = *(const GAS v4u*)(OG + goff); }
    *(LAS v4u*)(RG + tid * 8) = rg; *(LAS v4u*)(RK + tid * 8) = rk; *(LAS v4u*)(RV + tid * 8) = rv; if (FULL) { *(LAS v4u*)(RQ + tid * 8) = rq; *(LAS v4u*)(RO + tid * 8) = rog; }
    { const size_t g1 = goff + (size_t)32 * HW; rg = *(const GAS v4u*)(Gl + g1); rk = *(const GAS v4u*)(KK + g1); rv = *(const GAS v4u*)(Vv + g1); if (FULL) { rq = *(const GAS v4u*)(QS + g1); rog = *(const GAS v4u*)(OG + g1); } }
    __syncthreads();
#pragma unroll 1
    for (int blk = 0; blk < 16; ++blk) {
        const int t0 = t00 + 32 * blk;
        float c[8]; c[0] = bf2f(RG[(8 * ro) * 128 + k]);
#pragma unroll
        for (int j = 1; j < 8; ++j) c[j] = c[j - 1] + bf2f(RG[(8 * ro + j) * 128 + k]);
        OCT[ro * 128 + k] = c[7];
        __syncthreads();
        if (FULL && blk > 0 && !(VAR & 1)) *(GAS v4u*)(YH + goff + (size_t)(32 * (blk - 1)) * HW) = *(const LAS v4u*)(YT + tid * 8);
        const float o0 = OCT[k], o1 = OCT[128 + k], o2 = OCT[256 + k], o3 = OCT[384 + k];
        const float off = (ro > 0 ? o0 : 0.f) + (ro > 1 ? o1 : 0.f) + (ro > 2 ? o2 : 0.f); const float b32 = (o0 + o1) + (o2 + o3);
        btot += b32;
        { unsigned kdw[4], vw[4];
#pragma unroll
          for (int j = 0; j < 8; j += 2) {
              const float b0 = off + c[j], b1 = off + c[j + 1]; const float k0 = bf2f(RK[(8 * ro + j) * 128 + k]), k1 = bf2f(RK[(8 * ro + j + 1) * 128 + k]);
              kdw[j >> 1] = cvt_pk_bf16(k0 * EX2(b32 - b0), k1 * EX2(b32 - b1)); vw[j >> 1] = (unsigned)RV[(8 * ro + j) * 128 + k] | ((unsigned)RV[(8 * ro + j + 1) * 128 + k] << 16);
              if (FULL && !(VAR & 8)) { const float e0 = EX2(b0), e1 = EX2(b1); const float i0 = EX2(fminf(-b0, 120.f)), i1 = EX2(fminf(-b1, 120.f));
                  const unsigned qw = cvt_pk_bf16(bf2f(RQ[(8 * ro + j) * 128 + k]) * e0, bf2f(RQ[(8 * ro + j + 1) * 128 + k]) * e1), kw = cvt_pk_bf16(k0 * i0, k1 * i1);
                  QA[(8 * ro + j) * 136 + k] = (bf16)qw; QA[(8 * ro + j + 1) * 136 + k] = (bf16)(qw >> 16);
                  KA[(8 * ro + j) * 136 + k] = (bf16)kw; KA[(8 * ro + j + 1) * 136 + k] = (bf16)(kw >> 16); }
          }
          *(LAS v4u*)(KDT + k * 40 + 8 * ro) = (v4u){kdw[0], kdw[1], kdw[2], kdw[3]};
          *(LAS v4u*)(VT + k * 40 + 8 * ro) = (v4u){vw[0], vw[1], vw[2], vw[3]}; }
        if (ro == 0) DEC[k] = EX2(b32);
        unsigned short og[8];
        if (FULL) {
#pragma unroll
            for (int kb = 0; kb < 8; ++kb) { v2u wv; wv.x = cvt_pk_bf16(S[kb][0], S[kb][1]); wv.y = cvt_pk_bf16(S[kb][2], S[kb][3]); *(LAS v2u*)(ST + (16 * w + fr) * 136 + 16 * kb + 4 * q) = wv; }
#pragma unroll
            for (int tb = 0; tb < 2; ++tb)
#pragma unroll
                for (int r = 0; r < 4; ++r) og[tb * 4 + r] = RO[(16 * tb + 4 * q + r) * 128 + 16 * w + fr];
        }
        __syncthreads();
        if (blk < 15) {
            *(LAS v4u*)(RG + tid * 8) = rg; *(LAS v4u*)(RK + tid * 8) = rk; *(LAS v4u*)(RV + tid * 8) = rv; if (FULL) { *(LAS v4u*)(RQ + tid * 8) = rq; *(LAS v4u*)(RO + tid * 8) = rog; }
            if (blk < 14) { const size_t g2 = goff + (size_t)(32 * (blk + 2)) * HW; rg = *(const GAS v4u*)(Gl + g2); rk = *(const GAS v4u*)(KK + g2); rv = *(const GAS v4u*)(Vv + g2); if (FULL) { rq = *(const GAS v4u*)(QS + g2); rog = *(const GAS v4u*)(OG + g2); } }
        }
        f32x4 oacc[2] = {(f32x4){0.f, 0.f, 0.f, 0.f}, (f32x4){0.f, 0.f, 0.f, 0.f}};
        const bf16x8_t bV = *(const LAS bf16x8_t*)(VT + (16 * w + fr) * 40 + 8 * q);
        if (FULL) {
            if (w < 3 && !(VAR & 2)) {
                const int tb = w > 0 ? 1 : 0, sb = w > 1 ? 1 : 0; f32x4 pa = (f32x4){0.f, 0.f, 0.f, 0.f};
#pragma unroll
                for (int kk = 0; kk < 4; ++kk) { const bf16x8_t a = *(const LAS bf16x8_t*)(QA + (16 * tb + fr) * 136 + 32 * kk + 8 * q); const bf16x8_t b = *(const LAS bf16x8_t*)(KA + (16 * sb + fr) * 136 + 32 * kk + 8 * q);
                    pa = __builtin_amdgcn_mfma_f32_16x16x32_bf16(a, b, pa, 0, 0, 0); }
#pragma unroll
                for (int r = 0; r < 4; r += 2) { const int t = 16 * tb + 4 * q + r, s_ = 16 * sb + fr; const unsigned pw = cvt_pk_bf16(s_ <= t ? pa[r] : 0.f, s_ <= t + 1 ? pa[r + 1] : 0.f);
                    Pm[t * 40 + s_] = (bf16)pw; Pm[(t + 1) * 40 + s_] = (bf16)(pw >> 16); }
            }
            if (!(VAR & 4))
#pragma unroll
            for (int tb = 0; tb < 2; ++tb)
#pragma unroll
                for (int kk = 0; kk < 4; ++kk) { const bf16x8_t a = *(const LAS bf16x8_t*)(QA + (16 * tb + fr) * 136 + 32 * kk + 8 * q); const bf16x8_t b = *(const LAS bf16x8_t*)(ST + (16 * w + fr) * 136 + 32 * kk + 8 * q);
                    oacc[tb] = __builtin_amdgcn_mfma_f32_16x16x32_bf16(a, b, oacc[tb], 0, 0, 0); }
        }
#pragma unroll
        for (int kb = 0; kb < 8; ++kb) { const f32x4 d4 = *(const LAS f32x4*)(DEC + 16 * kb + 4 * q); const bf16x8_t a = *(const LAS bf16x8_t*)(KDT + (16 * kb + fr) * 40 + 8 * q);
            S[kb] = __builtin_amdgcn_mfma_f32_16x16x32_bf16(a, bV, S[kb] * d4, 0, 0, 0); }
        __syncthreads();
        if (FULL) {
#pragma unroll
            for (int tb = 0; tb < 2; ++tb) { const bf16x8_t a = *(const LAS bf16x8_t*)(Pm + (16 * tb + fr) * 40 + 8 * q); oacc[tb] = __builtin_amdgcn_mfma_f32_16x16x32_bf16(a, bV, oacc[tb], 0, 0, 0); }
            if (VAR & 1) { asm volatile("" :: "v"(oacc[0]), "v"(oacc[1])); } else {
            float ssv[8];
#pragma unroll
            for (int tb = 0; tb < 2; ++tb)
#pragma unroll
                for (int r = 0; r < 4; ++r) ssv[tb * 4 + r] = dpp_xor_sum16(oacc[tb][r] * oacc[tb][r]);
            if (fr == 0) {
#pragma unroll
                for (int tb = 0; tb < 2; ++tb)
#pragma unroll
                    for (int r = 0; r < 4; ++r) SSQ[(16 * tb + 4 * q + r) * 8 + w] = ssv[tb * 4 + r]; }
            __syncthreads();
#pragma unroll
            for (int tb = 0; tb < 2; ++tb) { float yv[4];
#pragma unroll
                for (int r = 0; r < 4; ++r) { const int t = 16 * tb + 4 * q + r; const f32x4 p0 = *(const LAS f32x4*)(SSQ + t * 8), p1 = *(const LAS f32x4*)(SSQ + t * 8 + 4);
                    const float tot = ((p0[0] + p0[1]) + (p0[2] + p0[3])) + ((p1[0] + p1[1]) + (p1[2] + p1[3])); const float rinv = __builtin_amdgcn_rsqf(tot * (1.0f / HD) + EPS);
                    yv[r] = oacc[tb][r] * rinv * hn * bf2f(og[tb * 4 + r]); }
                const unsigned y01 = cvt_pk_bf16(yv[0], yv[1]), y23 = cvt_pk_bf16(yv[2], yv[3]); const int tq = 16 * tb + 4 * q, cv_ = 16 * w + fr;
                YT[tq * 128 + cv_] = (bf16)y01; YT[(tq + 1) * 128 + cv_] = (bf16)(y01 >> 16); YT[(tq + 2) * 128 + cv_] = (bf16)y23; YT[(tq + 3) * 128 + cv_] = (bf16)(y23 >> 16); }
            }
        }
    }
    if (FULL && !(VAR & 1)) { __syncthreads(); *(GAS v4u*)(YH + goff + (size_t)(32 * 15) * HW) = *(const LAS v4u*)(YT + tid * 8); }
    if (!FULL) {
#pragma unroll
        for (int kb = 0; kb < 8; ++kb)
#pragma unroll
            for (int r = 0; r < 4; ++r) Ubuf[(item << 14) + (size_t)(16 * kb + 4 * q + r) * 128 + 16 * w + fr] = S[kb][r];
        if (ro == 0) Dtot[item * 128 + k] = EX2(btot);
    }
    __syncthreads();
}

#undef EX2
struct Args { const float* in[15]; float* out; unsigned char* ws; int ph_lo, ph_hi, li, pad; };

__global__ void __launch_bounds__(NWAVES * 64, 2) fwd(Args args) {
    extern __shared__ __attribute__((aligned(16))) unsigned char lds[];
    Frame F;
    F.lds = (LAS unsigned char*)lds;
    F.MISC = (volatile LAS unsigned*)(F.lds + MISC_OFF);
    F.tid = threadIdx.x; F.lane = F.tid & 63; F.wave = __builtin_amdgcn_readfirstlane(F.tid >> 6);
    F.G = gridDim.x; { const int bx = blockIdx.x; F.vcu = (F.G % 8 == 0) ? (bx % 8) * (F.G / 8) + bx / 8 : bx; }
    unsigned char* ws = args.ws;
    F.ctl = (gu32*)(ws + WS_CTL);
    const float* x = args.in[0]; const float* g_mix = args.in[1]; const float* w_in = args.in[2]; const float* w_pg = args.in[3]; const float* pool_scale = args.in[4];
    const float* lb_param = args.in[5]; const float* hgrn_norm = args.in[6]; const float* w_up_pool = args.in[7]; const float* w_up_hgrn = args.in[8]; const float* w_out = args.in[9];
    const float* g_ffn = args.in[10]; const float* w_gate = args.in[11]; const float* w_up = args.in[12]; const float* w_down = args.in[13]; const float* g_final = args.in[14];
    float* out = args.out;
    bf16* WinT = (bf16*)(ws + WS_WIN); bf16* WpgT = (bf16*)(ws + WS_WPG); bf16* WupT = (bf16*)(ws + WS_WUP); bf16* WuhT = (bf16*)(ws + WS_WUH); bf16* WoT = (bf16*)(ws + WS_WO);
    bf16* WguT = (bf16*)(ws + WS_WGU); bf16* WdT = (bf16*)(ws + WS_WD);
    bf16* U = (bf16*)(ws + WS_U); bf16* MG = U;
    bf16* Zb = (bf16*)(ws + WS_Z); bf16* QSb = (bf16*)(ws + WS_QS); bf16* Gb = (bf16*)(ws + WS_G); bf16* KKb = (bf16*)(ws + WS_KK); bf16* Vb = (bf16*)(ws + WS_V); bf16* OGb = (bf16*)(ws + WS_OG);
    bf16* GAb = (bf16*)(ws + WS_GA); bf16* GBb = (bf16*)(ws + WS_GB); bf16* ACT = (bf16*)(ws + WS_ACT);
    bf16* Pb = (bf16*)(ws + WS_P); bf16* YP = (bf16*)(ws + WS_YP); bf16* YH = (bf16*)(ws + WS_YH); bf16* H1B = (bf16*)(ws + WS_H1B);
    float* HU = (float*)(ws + WS_HU); float* HS = (float*)(ws + WS_HS); float* HDt = (float*)(ws + WS_HD); float* SSQ1 = (float*)(ws + WS_SSQ1); float* SSQ2 = (float*)(ws + WS_SSQ2); float* RS1 = (float*)(ws + WS_RS1);

    for (int u = F.tid; u < (LDS_BYTES - LDSCTL_OFF) / 4; u += NWAVES * 64) ((LAS unsigned*)(F.lds + LDSCTL_OFF))[u] = 0u;
    __syncthreads();
    XcdBarrier bar; bar.bar = (unsigned*)(F.ctl + 4096); bar.x = 0; bar.st = nullptr;
    if (N_LAUNCHES == 1) bar = xcd_barrier_post((unsigned*)(F.ctl + 4096), F.MISC + 8);
#define GRID_BAR() do { if (N_LAUNCHES == 1) xcd_barrier(bar); } while (0)
    const int lo = args.ph_lo, hi = args.ph_hi;
#define IN(k) (lo <= (k) && (k) < hi)
#define BOTH(k) (IN(k) && IN((k) + 1))
    const int gw = F.vcu * NWAVES + F.wave, NGW = F.G * NWAVES;
    const int gt = F.vcu * (NWAVES * 64) + F.tid, NGT = F.G * NWAVES * 64;

    if (IN(0)) {
        LAS float* scr = (LAS float*)(F.lds + RING_OFF + F.wave * 16384);
        p0_transpose_matrix(w_in, D, NIN, WinT, D, 0, scr, gw, NGW, F.lane);
#pragma unroll 1
        for (int gi = 0; gi < 4; ++gi) p0_transpose_matrix(w_pg + (size_t)gi * 512 * 512, 512, 512, WpgT + (size_t)gi * 512 * 512, 512, 0, scr, gw, NGW, F.lane);
        p0_transpose_matrix(w_up_pool, PW, D, WupT, PW, 0, scr, gw, NGW, F.lane);
        p0_transpose_matrix(w_up_hgrn, HW, D, WuhT, HW, 0, scr, gw, NGW, F.lane);
        p0_transpose_matrix(w_out, D, D, WoT, D, 0, scr, gw, NGW, F.lane);
        p0_transpose_matrix(w_gate, D, DFF, WguT, D, 1, scr, gw, NGW, F.lane);
        p0_transpose_matrix(w_up, D, DFF, WguT, D, 2, scr, gw, NGW, F.lane);
        for (int m = gw; m < T; m += NGW) {
            const GAS f32x4* xr = (const GAS f32x4*)(x + (size_t)m * D) + F.lane; const GAS f32x4* gr = (const GAS f32x4*)g_mix + F.lane;
            f32x4 v[16]; float s = 0.f;
#pragma unroll
            for (int j = 0; j < 16; ++j) { v[j] = xr[64 * j]; s += (v[j][0] * v[j][0] + v[j][1] * v[j][1]) + (v[j][2] * v[j][2] + v[j][3] * v[j][3]); }
            const float r = 1.0f / sqrtf(wave_sum(s) * (1.0f / D) + EPS);
            GAS v2u* o8 = (GAS v2u*)(U + (size_t)m * D) + F.lane;
#pragma unroll
            for (int j = 0; j < 16; ++j) { const f32x4 gg = gr[64 * j]; v2u w; w.x = pk2(v[j][0] * r * gg[0], v[j][1] * r * gg[1]); w.y = pk2(v[j][2] * r * gg[2], v[j][3] * r * gg[3]); o8[64 * j] = w; }
        }
        if (BOTH(0)) GRID_BAR();
    }
    if (IN(1)) {
        pg8::Gemm g{U, WinT, T, NIN, D, D, D, 0, 0}; pg8::StaticOrder S; S.init(T, NIN, F.G, (int)blockIdx.x);
        EpiProj E{Zb, lb_param};
        pg8::gemm_phase<EpiProj, pg8::StaticOrder, true, true>(F.lds + RING_OFF, g, S, E);
        if (BOTH(1)) GRID_BAR();
    }
    if (IN(2)) {
        for (int it = gw; it < (T / 4) * 4; it += NGW) {
            const int t4 = (it >> 2) * 4, gi = it & 3, c8 = gi * 512 + F.lane * 8;
            if (gi == 0) pool_item<2>(Zb, Pb, t4, c8); else if (gi == 1) pool_item<4>(Zb, Pb, t4, c8); else if (gi == 2) pool_item<8>(Zb, Pb, t4, c8); else pool_item<16>(Zb, Pb, t4, c8);
        }
        for (int b = F.vcu; b < NH * 16; b += F.G)
            hgrn_pass<false>(F.lds + RING_OFF, b >> 4, b & 15, QSb, Gb, KKb, Vb, OGb, hgrn_norm, HU, HDt, HS, YH, F.tid, F.lane, F.wave);
        if (BOTH(2)) GRID_BAR();
    }
    if (IN(3)) {
        pg8::Gemm g{Pb, WpgT, T, PW, 512, PW, 512, 1, 512}; pg8::StaticOrder S; S.init(T, PW, F.G, (int)blockIdx.x);
        EpiScaleBf16 E{YP, PW, pool_scale};
        pg8::gemm_phase<EpiScaleBf16, pg8::StaticOrder, true, true>(F.lds + RING_OFF, g, S, E);
        for (int e = gt; e < NH * HD * HD; e += NGT) {
            const int h = e >> 14, kv = e & 16383, k = kv >> 7; float Sc = 0.f;
#pragma unroll
            for (int sc = 0; sc < 16; ++sc) { const size_t it = (size_t)(h * 16 + sc); HS[(it << 14) + kv] = Sc; Sc = HDt[it * 128 + k] * Sc + HU[(it << 14) + kv]; }
        }
        if (BOTH(3)) GRID_BAR();
    }
    if (IN(4)) {
        for (int b = F.vcu; b < NH * 16; b += F.G)
            hgrn_pass<true>(F.lds + RING_OFF, b >> 4, b & 15, QSb, Gb, KKb, Vb, OGb, hgrn_norm, HU, HDt, HS, YH, F.tid, F.lane, F.wave);
        { pg8::Gemm g{YP, WupT, T, D, PW, PW, PW, 0, 0}; pg8::StaticOrder S; S.init(T, D, F.G, (int)blockIdx.x);
          EpiGateF32 E{out, GAb};
          pg8::gemm_phase<EpiGateF32, pg8::StaticOrder, true, true>(F.lds + RING_OFF, g, S, E); }
        if (BOTH(4)) GRID_BAR();
    }
    if (IN(5)) {
        { pg8::Gemm g{YH, WuhT, T, D, HW, HW, HW, 0, 0}; pg8::StaticOrder S; S.init(T, D, F.G, (int)blockIdx.x);
          EpiGateAddBf16 E{out, GBb, MG};
          pg8::gemm_phase<EpiGateAddBf16, pg8::StaticOrder, true, true>(F.lds + RING_OFF, g, S, E); }
        if (BOTH(5)) GRID_BAR();
    }
    if (IN(6)) {
        pg8::Gemm g{MG, WoT, T, D, D, D, D, 0, 0}; pg8::StaticOrder S; S.init(T, D, F.G, (int)blockIdx.x);
        EpiResid<true> E{x, out, H1B, g_ffn, SSQ1};
        pg8::gemm_phase<EpiResid<true>, pg8::StaticOrder, true, true>(F.lds + RING_OFF, g, S, E);
        if (BOTH(6)) GRID_BAR();
    }
    if (IN(7)) {
    }
    if (IN(8)) {
        pg8::Gemm g{H1B, WguT, T, 2 * DFF, D, D, D, 0, 0}; pg8::StaticOrder S; S.init(T, 2 * DFF, F.G, (int)blockIdx.x);
        { pg8::Unit ux; int nun = 0; while (S.next(nun, ux)) ++nun;
          const int nmax = (32 * 86 + F.G - 1) / F.G; const int nspare = (nmax * F.G - 32 * 86);
          if (nun < nmax && nspare > 0) { LAS float* scr = (LAS float*)(F.lds + RING_OFF + F.wave * 16384);
              p0_transpose_matrix(w_down, DFF, D, WdT, DFF, 0, scr, ((int)blockIdx.x - (F.G - nspare)) * NWAVES + F.wave, nspare * NWAVES, F.lane); }
          else if (nspare == 0) { LAS float* scr = (LAS float*)(F.lds + RING_OFF + F.wave * 16384); p0_transpose_matrix(w_down, DFF, D, WdT, DFF, 0, scr, gw, NGW, F.lane); } }
        LAS float* rsl = (LAS float*)(F.lds + RS_OFF);
        { pg8::Unit u0; int pm_lo = 1 << 30, pm_hi = -1;
          for (int i = 0; S.next(i, u0); ++i) { pm_lo = u0.pm < pm_lo ? u0.pm : pm_lo; pm_hi = u0.pm > pm_hi ? u0.pm : pm_hi; }
          for (int pmx = pm_lo; pmx <= pm_hi && pmx < pm_lo + RS_PANELS; ++pmx)
              for (int r = F.tid; r < 256; r += NWAVES * 64) { float sq = 0.f;
#pragma unroll 8
                  for (int p = 0; p < 64; ++p) sq += SSQ1[(size_t)p * T + pmx * 256 + r];
                  rsl[(pmx - pm_lo) * 256 + r] = 1.0f / sqrtf(sq * (1.0f / D) + EPS); }
          __syncthreads();
          EpiSwiGLU E{ACT, rsl, pm_lo};
          pg8::gemm_phase<EpiSwiGLU, pg8::StaticOrder, true, true>(F.lds + RING_OFF, g, S, E); }
        if (BOTH(8)) GRID_BAR();
    }
    if (IN(9)) {
        pg8::Gemm g{ACT, WdT, T, D, DFF, DFF, DFF, 0, 0}; pg8::StaticOrder S; S.init(T, D, F.G, (int)blockIdx.x);
        EpiResid<false> E{out, out, nullptr, nullptr, SSQ2};
        pg8::gemm_phase<EpiResid<false>, pg8::StaticOrder, true, true>(F.lds + RING_OFF, g, S, E);
        if (BOTH(9)) GRID_BAR();
    }
    if (IN(10)) {
        for (int m = gw; m < T; m += NGW) {
            const float r = 1.0f / sqrtf(wave_sum(SSQ2[(size_t)F.lane * T + m]) * (1.0f / D) + EPS);
            GAS f32x4* orow = (GAS f32x4*)(out + (size_t)m * D) + F.lane; const GAS f32x4* gr = (const GAS f32x4*)g_final + F.lane;
#pragma unroll
            for (int j = 0; j < 16; ++j) { const f32x4 v = orow[64 * j]; const f32x4 gg = gr[64 * j]; orow[64 * j] = v * r * gg; }
        }
    }
#if PROBE_DUP >= 11
    if (IN(11)) {
        pg8::Gemm g{U, WinT, T, NIN, D, D, D, 0, 0}; pg8::StaticOrder S; S.init(T, NIN, F.G, (int)blockIdx.x);
        EpiNull E{};
        pg8::gemm_phase<EpiNull, pg8::StaticOrder, true, true>(F.lds + RING_OFF, g, S, E);
    }
    if (IN(12)) {
        pg8::Gemm g{ACT, WdT, T, D, DFF, DFF, DFF, 0, 0}; pg8::StaticOrder S; S.init(T, D, F.G, (int)blockIdx.x);
        EpiNull E{};
        pg8::gemm_phase<EpiNull, pg8::StaticOrder, true, true>(F.lds + RING_OFF, g, S, E);
    }
    if (IN(14)) { for (int b = F.vcu; b < NH * 16; b += F.G) hgrn_pass<true>(F.lds + RING_OFF, b >> 4, b & 15, QSb, Gb, KKb, Vb, OGb, hgrn_norm, HU, HDt, HS, YH, F.tid, F.lane, F.wave); }
    if (IN(15)) { for (int b = F.vcu; b < NH * 16; b += F.G) hgrn_pass<false>(F.lds + RING_OFF, b >> 4, b & 15, QSb, Gb, KKb, Vb, OGb, hgrn_norm, HU, HDt, HS, YH, F.tid, F.lane, F.wave); }
    if (IN(16)) { for (int it = gw; it < (T / 4) * 4; it += NGW) { const int t4 = (it >> 2) * 4, gi = it & 3, c8 = gi * 512 + F.lane * 8;
            if (gi == 0) pool_item<2>(Zb, Pb, t4, c8); else if (gi == 1) pool_item<4>(Zb, Pb, t4, c8); else if (gi == 2) pool_item<8>(Zb, Pb, t4, c8); else pool_item<16>(Zb, Pb, t4, c8); } }
#endif
#undef IN
#undef BOTH
#undef GRID_BAR
}

extern "C" void kernel_launch(void* const* d_in, const int* in_sizes, int n_in, void* d_out, int out_size, void* d_ws, size_t ws_size, hipStream_t stream) {
    static int grid = 0;
    if (grid == 0) {
        if (n_in != 15 || in_sizes[0] != T * D || out_size != T * D || ws_size < WS_END) { fprintf(stderr, "kernel_launch: unexpected shapes: n_in %d in0 %d out %d ws %zu (need %zu)\n", n_in, n_in > 0 ? in_sizes[0] : -1, out_size, ws_size, (size_t)WS_END); grid = -1; return; }
        int dev = 0, cus = 0, per_cu = 0;
        if (hipGetDevice(&dev) != hipSuccess || hipDeviceGetAttribute(&cus, hipDeviceAttributeMultiprocessorCount, dev) != hipSuccess) { grid = -1; return; }
        if (hipFuncSetAttribute((const void*)fwd, hipFuncAttributeMaxDynamicSharedMemorySize, LDS_BYTES) != hipSuccess) { fprintf(stderr, "kernel_launch: hipFuncSetAttribute failed\n"); grid = -1; return; }
        if (hipOccupancyMaxActiveBlocksPerMultiprocessor(&per_cu, (const void*)fwd, NWAVES * 64, LDS_BYTES) != hipSuccess || per_cu < 1) fprintf(stderr, "kernel_launch: occupancy query says %d\n", per_cu);
        (void)hipGetLastError();
        grid = cus;
    }
    if (grid < 0) return;
    if (hipMemsetAsync((char*)d_ws + WS_CTL, 0, CTL_ZERO_BYTES, stream) != hipSuccess) return;
    Args a{};
    for (int i = 0; i < 15; ++i) a.in[i] = (const float*)d_in[i];
    a.out = (float*)d_out; a.ws = (unsigned char*)d_ws;
    for (int li = 0; li < N_LAUNCHES; ++li) {
        a.ph_lo = (N_LAUNCHES == NPHASE) ? li : 0; a.ph_hi = (N_LAUNCHES == NPHASE) ? li + 1 : NPHASE; a.li = li;
        hipLaunchKernelGGL(fwd, dim3(grid), dim3(NWAVES * 64), LDS_BYTES, stream, a);
        const hipError_t le = hipPeekAtLastError();
        if (le != hipSuccess) { fprintf(stderr, "kernel_launch: launch %d failed: %s\n", li, hipGetErrorName(le)); break; }
    }
    if (N_LAUNCHES == NPHASE && PROBE_DUP >= 0) {
        a.ph_lo = PROBE_DUP; a.ph_hi = PROBE_DUP + 1; a.li = 0;
        for (int rep = 0; rep < PROBE_REPS; ++rep) hipLaunchKernelGGL(fwd, dim3(grid), dim3(NWAVES * 64), LDS_BYTES, stream, a);
    }
}
```
